# Optimizing an MI355X kernel written in HIP

```python
import jax, jax.numpy as jnp
from jax import lax
import numpy as np

D_MODEL = 2048
BATCH = 4
SEQ = 2048
DEPTH = 1
DEC_BATCH = 8
DEC_SEQ = 16
PAST_LEN = 1024

CHUNK = 64
N_PREV_CHUNKS = 8
BAND_CHUNKS = N_PREV_CHUNKS + 1
ATT_REACH = N_PREV_CHUNKS * CHUNK
HEAD_DIM = 64
N_ATT_HEADS = 16
N_RWKV_HEADS = 16
D_ATT = N_ATT_HEADS * HEAD_DIM
D_RWKV = N_RWKV_HEADS * HEAD_DIM
D_MIX = D_ATT + D_RWKV
REL_CLIP = 128
N_REL = 2 * REL_CLIP + 1
RANK_W = 64
RANK_A = 64
RANK_G = 128
D_SHIFT = 3 * D_RWKV + RANK_W + RANK_A + RANK_G
D_IN = 3 * D_ATT + D_SHIFT
RWKV_SPLITS = (D_RWKV, 2 * D_RWKV, 3 * D_RWKV, 3 * D_RWKV + RANK_W, 3 * D_RWKV + RANK_W + RANK_A)
D_FF = 5632
CONV_W = 3
RMS_EPS = 1e-6
GN_EPS = 64e-5
ATT_SCALE = HEAD_DIM ** -0.5
NEG_INF = -1e30

kernel_name = 'chunk_band_attn_rwkv7_hybrid_step'


def rms_norm(x, g):
    xf = x.astype(jnp.float32)
    y = xf * lax.rsqrt(jnp.mean(xf * xf, axis=-1, keepdims=True) + RMS_EPS)
    return (y * g.astype(jnp.float32)).astype(x.dtype)


def rel_bias(table, n_q, n_k, q_offset):
    rel = q_offset + jnp.arange(n_q)[:, None] - jnp.arange(n_k)[None, :]
    idx = jnp.clip(rel, -REL_CLIP, REL_CLIP) + REL_CLIP
    return table.astype(jnp.float32)[:, idx]


def band_attend(qb, kb, vb, bias, mask=None):
    s = jnp.einsum('bnqhd,bnkhd->bnhqk', qb, kb).astype(jnp.float32) * ATT_SCALE + bias
    if mask is not None:
        s = jnp.where(mask, s, NEG_INF)
    p = jax.nn.softmax(s, axis=-1).astype(vb.dtype)
    return jnp.einsum('bnhqk,bnkhd->bnqhd', p, vb)


def chunk_band_attention(q, k, v, table):
    B, S, H, dh = q.shape
    NC = S // CHUNK
    pad = jnp.zeros((B, ATT_REACH, H, dh), k.dtype)
    kc = jnp.concatenate([pad, k], axis=1).reshape(B, NC + N_PREV_CHUNKS, CHUNK, H, dh)
    vc = jnp.concatenate([pad, v], axis=1).reshape(B, NC + N_PREV_CHUNKS, CHUNK, H, dh)
    band = jnp.arange(NC)[:, None] + jnp.arange(BAND_CHUNKS)[None, :]
    kb = kc[:, band].reshape(B, NC, BAND_CHUNKS * CHUNK, H, dh)
    vb = vc[:, band].reshape(B, NC, BAND_CHUNKS * CHUNK, H, dh)
    key_pos = (jnp.arange(NC)[:, None] - N_PREV_CHUNKS) * CHUNK + jnp.arange(BAND_CHUNKS * CHUNK)[None, :]
    mask = (key_pos >= 0)[None, :, None, None, :]
    bias = rel_bias(table, CHUNK, BAND_CHUNKS * CHUNK, ATT_REACH)
    out = band_attend(q.reshape(B, NC, CHUNK, H, dh), kb, vb, bias, mask)
    return out.reshape(B, S, H, dh)


def cached_chunk_attention(q, k, v, k_past, v_past, table):
    R = k_past.shape[1]
    T = q.shape[1]
    kb = jnp.concatenate([k_past.astype(k.dtype), k], axis=1)[:, None]
    vb = jnp.concatenate([v_past.astype(v.dtype), v], axis=1)[:, None]
    bias = rel_bias(table, T, R + T, R)
    return band_attend(q[:, None], kb, vb, bias)[:, 0]


def rwkv7_scan(S0, r, decay, k, v, kk, a):
    def step(S, inp):
        r_t, w_t, k_t, v_t, kk_t, a_t = inp
        sa = jnp.einsum('bhvk,bhk->bhv', S, -kk_t)
        S = (S * w_t[:, :, None, :] + sa[..., None] * (kk_t * a_t)[:, :, None, :]
             + v_t[..., None] * k_t[:, :, None, :])
        return S, jnp.einsum('bhvk,bhk->bhv', S, r_t)
    xs = tuple(jnp.swapaxes(t, 0, 1) for t in (r, decay, k, v, kk, a))
    S, ys = lax.scan(step, S0, xs)
    return jnp.swapaxes(ys, 0, 1), S


def rwkv7_time_mix(z, shift_prev, S0, p):
    B, T, _ = z.shape
    f32 = jnp.float32
    z_prev = jnp.concatenate([shift_prev.astype(z.dtype)[:, None], z[:, :-1]], axis=1)
    zs = z + (z_prev - z) * p['mu_shift']
    r, k, v, wd, ad, gd = jnp.split(zs, RWKV_SPLITS, axis=-1)
    w_log = -jax.nn.softplus(-(p['w0'] + jnp.tanh(wd) @ p['w2']).astype(f32)) - 0.5
    decay = jnp.exp(-jnp.exp(w_log))
    a = jax.nn.sigmoid((p['a0'] + ad @ p['a2']).astype(f32))
    g = jax.nn.sigmoid(gd) @ p['g2']
    hd = lambda t: t.astype(f32).reshape(B, T, N_RWKV_HEADS, HEAD_DIM)
    ph = lambda t: t.astype(f32).reshape(N_RWKV_HEADS, HEAD_DIM)
    r, k, v, decay, a = hd(r), hd(k), hd(v), hd(decay), hd(a)
    kk = k * ph(p['k_k'])
    kk = kk / jnp.maximum(jnp.sqrt(jnp.sum(kk * kk, axis=-1, keepdims=True)), 1e-12)
    k = k * (1.0 + (a - 1.0) * ph(p['k_a']))
    y, S = rwkv7_scan(S0, r, decay, k, v, kk, a)
    mu = jnp.mean(y, axis=-1, keepdims=True)
    var = jnp.mean(jnp.square(y - mu), axis=-1, keepdims=True)
    yn = ((y - mu) * lax.rsqrt(var + GN_EPS)).reshape(B, T, D_RWKV)
    yn = yn * p['ln_x_w'].astype(f32) + p['ln_x_b'].astype(f32)
    bonus = jnp.sum(r * k * p['r_k'].astype(f32), axis=-1, keepdims=True) * v
    out = (yn + bonus.reshape(B, T, D_RWKV)).astype(z.dtype) * g
    return out, S, z[:, -1]


def causal_dwconv(h, h_past, w, b):
    T = h.shape[1]
    hp = jnp.concatenate([h_past.astype(h.dtype), h], axis=1)
    out = b + hp[:, 0:T] * w[0]
    for j in range(1, CONV_W):
        out = out + hp[:, j:j + T] * w[j]
    return out, hp[:, -(CONV_W - 1):]


def layer(x, c, k_past, v_past, S0, shift_prev, conv_prev, p):
    B, T, _ = x.shape
    mod = jax.nn.silu(c) @ p['w_ada'] + p['b_ada']
    sh_a, sc_a, g_a, sh_f, sc_f, g_f = jnp.split(mod[:, None, :], 6, axis=-1)
    h = rms_norm(x, p['norm_att_g']) * (1 + sc_a) + sh_a
    z = h @ p['w_in']
    q = rms_norm(z[..., :D_ATT].reshape(B, T, N_ATT_HEADS, HEAD_DIM), p['q_norm_g'])
    k = rms_norm(z[..., D_ATT:2 * D_ATT].reshape(B, T, N_ATT_HEADS, HEAD_DIM), p['k_norm_g'])
    v = z[..., 2 * D_ATT:3 * D_ATT].reshape(B, T, N_ATT_HEADS, HEAD_DIM)
    if k_past is None:
        att = chunk_band_attention(q, k, v, p['rel_bias'])
    else:
        att = cached_chunk_attention(q, k, v, k_past, v_past, p['rel_bias'])
    rw, S, shift_last = rwkv7_time_mix(z[..., 3 * D_ATT:], shift_prev, S0, p)
    mix = jnp.concatenate([att.reshape(B, T, D_ATT), rw], axis=-1) @ p['w_out']
    x = x + g_a * mix
    h = rms_norm(x, p['norm_ffn_g']) * (1 + sc_f) + sh_f
    gate_pre, val = jnp.split(h @ p['w_up'], 2, axis=-1)
    gate_c, conv_last = causal_dwconv(gate_pre, conv_prev, p['dw_conv'], p['dw_bias'])
    x = x + g_f * ((jax.nn.gelu(gate_c, approximate=False) * val) @ p['w_down'])
    return x, k, v, S, shift_last, conv_last


def setup_inputs(seed: int = 0) -> dict:
    key = jax.random.key(seed)
    ks = iter(jax.random.split(key, 40))
    f32 = jnp.float32
    L = DEPTH
    R = min(ATT_REACH, PAST_LEN)

    def nrm(shape, scale=1.0):
        return scale * jax.random.normal(next(ks), shape, f32)

    return {
        'x_prompt': nrm((BATCH, SEQ, D_MODEL)),
        'x_sample': nrm((DEC_BATCH, DEC_SEQ, D_MODEL)),
        'c_prompt': nrm((BATCH, D_MODEL)),
        'c_sample': nrm((DEC_BATCH, D_MODEL)),
        'cache_att_k': nrm((L, DEC_BATCH, R, N_ATT_HEADS, HEAD_DIM)),
        'cache_att_v': nrm((L, DEC_BATCH, R, N_ATT_HEADS, HEAD_DIM)),
        'state_rwkv': nrm((L, DEC_BATCH, N_RWKV_HEADS, HEAD_DIM, HEAD_DIM)),
        'state_shift': nrm((L, DEC_BATCH, D_SHIFT)),
        'state_ffn_conv': nrm((L, DEC_BATCH, CONV_W - 1, D_FF)),
        'norm_att_g': 1.0 + nrm((L, D_MODEL), 0.1),
        'norm_ffn_g': 1.0 + nrm((L, D_MODEL), 0.1),
        'w_ada': nrm((L, D_MODEL, 6 * D_MODEL), 0.5 * D_MODEL ** -0.5),
        'b_ada': nrm((L, 6 * D_MODEL), 0.01),
        'w_in': nrm((L, D_MODEL, D_IN), D_MODEL ** -0.5),
        'q_norm_g': 1.0 + nrm((L, HEAD_DIM), 0.1),
        'k_norm_g': 1.0 + nrm((L, HEAD_DIM), 0.1),
        'rel_bias': nrm((L, N_ATT_HEADS, N_REL), 0.5),
        'mu_shift': jax.random.uniform(next(ks), (L, D_SHIFT), f32),
        'w0': jax.random.uniform(next(ks), (L, D_RWKV), f32, -5.0, 1.0),
        'w2': nrm((L, RANK_W, D_RWKV), 0.5 * RANK_W ** -0.5),
        'a0': nrm((L, D_RWKV), 0.5),
        'a2': nrm((L, RANK_A, D_RWKV), 0.5 * RANK_A ** -0.5),
        'g2': nrm((L, RANK_G, D_RWKV), RANK_G ** -0.5),
        'k_k': 1.0 + nrm((L, D_RWKV), 0.1),
        'k_a': 1.0 + nrm((L, D_RWKV), 0.1),
        'r_k': nrm((L, N_RWKV_HEADS, HEAD_DIM), 0.1),
        'ln_x_w': 1.0 + nrm((L, D_RWKV), 0.1),
        'ln_x_b': nrm((L, D_RWKV), 0.01),
        'w_out': nrm((L, D_MIX, D_MODEL), D_MIX ** -0.5),
        'w_up': nrm((L, D_MODEL, 2 * D_FF), D_MODEL ** -0.5),
        'dw_conv': nrm((L, CONV_W, D_FF), CONV_W ** -0.5),
        'dw_bias': nrm((L, D_FF), 0.01),
        'w_down': nrm((L, D_FF, D_MODEL), D_FF ** -0.5),
    }


def reference(x_prompt, x_sample, c_prompt, c_sample, cache_att_k, cache_att_v, state_rwkv,
              state_shift, state_ffn_conv, norm_att_g, norm_ffn_g, w_ada, b_ada, w_in,
              q_norm_g, k_norm_g, rel_bias, mu_shift, w0, w2, a0, a2, g2, k_k, k_a, r_k,
              ln_x_w, ln_x_b, w_out, w_up, dw_conv, dw_bias, w_down):
    hp, hs = x_prompt, x_sample
    Bp, Tp = hp.shape[0], hp.shape[1]
    keep = min(ATT_REACH, Tp)
    kp_l, vp_l, Sp_l, shp_l, cvp_l = [], [], [], [], []
    ks_l, vs_l, Ss_l, shs_l, cvs_l = [], [], [], [], []
    for l in range(DEPTH):
        p = dict(norm_att_g=norm_att_g[l], norm_ffn_g=norm_ffn_g[l], w_ada=w_ada[l], b_ada=b_ada[l],
                 w_in=w_in[l], q_norm_g=q_norm_g[l], k_norm_g=k_norm_g[l], rel_bias=rel_bias[l],
                 mu_shift=mu_shift[l], w0=w0[l], w2=w2[l], a0=a0[l], a2=a2[l], g2=g2[l],
                 k_k=k_k[l], k_a=k_a[l], r_k=r_k[l], ln_x_w=ln_x_w[l], ln_x_b=ln_x_b[l],
                 w_out=w_out[l], w_up=w_up[l], dw_conv=dw_conv[l], dw_bias=dw_bias[l], w_down=w_down[l])
        hp, kp, vp, Sp, shp, cvp = layer(
            hp, c_prompt, None, None,
            jnp.zeros((Bp, N_RWKV_HEADS, HEAD_DIM, HEAD_DIM), jnp.float32),
            jnp.zeros((Bp, D_SHIFT), hp.dtype),
            jnp.zeros((Bp, CONV_W - 1, D_FF), hp.dtype), p)
        kp_l.append(kp[:, Tp - keep:]); vp_l.append(vp[:, Tp - keep:])
        Sp_l.append(Sp.astype(hp.dtype)); shp_l.append(shp); cvp_l.append(cvp)
        hs, kn, vn, Sn, shn, cvn = layer(
            hs, c_sample, cache_att_k[l], cache_att_v[l],
            state_rwkv[l].astype(jnp.float32), state_shift[l], state_ffn_conv[l], p)
        ks_l.append(kn); vs_l.append(vn)
        Ss_l.append(Sn.astype(hs.dtype)); shs_l.append(shn); cvs_l.append(cvn)
    return (hp, hs,
            jnp.stack(kp_l), jnp.stack(vp_l), jnp.stack(Sp_l), jnp.stack(shp_l), jnp.stack(cvp_l),
            jnp.stack(ks_l), jnp.stack(vs_l), jnp.stack(Ss_l), jnp.stack(shs_l), jnp.stack(cvs_l))
```

```cpp
#include <hip/hip_runtime.h>
#include <hip/hip_cooperative_groups.h>
#include <cstdio>
namespace cg = cooperative_groups;

#ifndef PROG
#define PROG 0
#endif
#ifndef REPEAT_SUB
#define REPEAT_SUB 0
#endif
#ifndef REPEAT_PHASE
#define REPEAT_PHASE -1
#endif
#ifndef N_LAUNCH_PER_PHASE
#define N_LAUNCH_PER_PHASE 0
#endif

#define DI __device__ __forceinline__
#define LAS __attribute__((address_space(3)))
typedef unsigned short bf16_t;
typedef short bf16x8 __attribute__((ext_vector_type(8)));
typedef short s16x4 __attribute__((ext_vector_type(4)));
typedef float f32x2 __attribute__((ext_vector_type(2)));
typedef float f32x4 __attribute__((ext_vector_type(4)));
typedef float f32x16 __attribute__((ext_vector_type(16)));
typedef unsigned u32x2 __attribute__((ext_vector_type(2)));
typedef unsigned u32x4 __attribute__((ext_vector_type(4)));
typedef __bf16 bf16x2_t __attribute__((ext_vector_type(2)));

constexpr int DM = 2048, SEQ = 2048, MPR = 8192, MS = 128, MT = 8320, MPAD = 8448;
constexpr int DIN = 6400, DSH = 3328, DFF = 5632, NMOD = 12288;
constexpr float LOG2E = 1.4426950408889634f;
enum { I_XP = 0, I_XS, I_CP, I_CS, I_CK, I_CV, I_SR, I_SS, I_SC, I_NAG, I_NFG, I_WADA, I_BADA, I_WIN, I_QG, I_KG, I_RB, I_MU, I_W0, I_W2, I_A0, I_A2, I_G2,
       I_KK, I_KA, I_RK, I_LW, I_LB, I_WOUT, I_WUP, I_DWC, I_DWB, I_WDN };
constexpr size_t O_Y = 0, O_KP = 17039360, O_VP = 19136512, O_SP = 21233664, O_SHP = 21495808, O_CVP = 21509120, O_KS = 21554176, O_VS = 21685248,
                 O_SS = 21816320, O_SHS = 22340608, O_CVS = 22367232;
constexpr size_t WS_WT_OUT = 0, WS_WT_UP = 8388608, WS_WT_DOWN = 54525952, WS_LT = 77594624, WS_MODP = 78118912, WS_MOD = 82837504, WS_BONUS = 83427328,
                 WS_CTR = 83959808, WS_BAR = 83963904, WS_R = 83963904 + 16384;
constexpr size_t WS_WT_IN = WS_R, WS_H = WS_R + 26214400, WS_MIXIN = WS_R, WS_GG = WS_R + 305004544  , WS_QK = WS_R + 60817408, WS_VT = WS_R + 95420416,
                 WS_ZR = WS_R + 112721920, WS_Y = WS_ZR, WS_FW = WS_R + 168951808, WS_FB = WS_R + 203030528, WS_FV = WS_R + 271187968, WS_GV = WS_QK, WS_KC = WS_R + 288227328, WS_VTC = WS_R + 288227328 + 8388608;

struct Params { const float* in[33]; float* out; unsigned char* ws; int ph_lo, ph_hi; };

DI unsigned pk2(float a, float b) { f32x2 v = {a, b}; bf16x2_t r = __builtin_convertvector(v, bf16x2_t); return __builtin_bit_cast(unsigned, r); }
DI float bflo(unsigned u) { return __uint_as_float(u << 16); }
DI float bfhi(unsigned u) { return __uint_as_float(u & 0xffff0000u); }
DI float bf1(bf16_t u) { return __uint_as_float(((unsigned)u) << 16); }
DI void unpack8(u32x4 v, float* f) { f[0] = bflo(v.x); f[1] = bfhi(v.x); f[2] = bflo(v.y); f[3] = bfhi(v.y); f[4] = bflo(v.z); f[5] = bfhi(v.z); f[6] = bflo(v.w); f[7] = bfhi(v.w); }
DI void unpack4(u32x2 v, float* f) { f[0] = bflo(v.x); f[1] = bfhi(v.x); f[2] = bflo(v.y); f[3] = bfhi(v.y); }
DI float wave_sum(float v) {
#pragma unroll
    for (int o = 1; o < 64; o <<= 1) v += __shfl_xor(v, o);
    return v;
}
DI float dpp_ror_add(float s, int) { return s; }
#define DPP_ADD(s, ctrl) ((s) + __builtin_bit_cast(float, __builtin_amdgcn_update_dpp(0, __builtin_bit_cast(int, (s)), (ctrl), 0xf, 0xf, false)))
DI float row16_sum(float s) { s = DPP_ADD(s, 0x128); s = DPP_ADD(s, 0x124); s = DPP_ADD(s, 0x122); s = DPP_ADD(s, 0x121); return s; }
DI int crow(int reg, int h) { return (reg & 3) + 8 * (reg >> 2) + 4 * h; }
DI float sigmoidf_(float x) { return 1.f / (1.f + __expf(-x)); }
#define MFMA32(a, b, c) __builtin_amdgcn_mfma_f32_32x32x16_bf16((a), (b), (c), 0, 0, 0)

DI float gelu_f(float v) {
    const float av = fabsf(v), d = av * 0.2316418882f + 1.0f;
    const float t = __builtin_amdgcn_rcpf(d);
    float q = t * 0.5307027145f + (-0.7265760135f); q = q * t + 0.7107068705f; q = q * t + (-0.142248368f); q = q * t + 0.127414796f; q = q * t;
    const float e = __builtin_amdgcn_exp2f((v * v) * (-0.72134752044f));
    const float m = v * (q * e), r = v - m;
    return v < 0.f ? m : r;
}

namespace pg8 {
constexpr int BM = 256, BK = 64, HALF = 128, HTB = HALF * BK * 2, STAGE_BYTES = 8 * HTB;
DI int lds_byte(int r, int c) { const int st = (r >> 4) * 2 + (c >> 5), rr = r & 15, cc = c & 31, ob = rr * 64 + cc * 2; return st * 1024 + (ob ^ (((ob >> 9) & 1) << 5)); }
DI void stage_rc(int b, int& R, int& C) { const int st = b / 1024, sb = b % 1024, swz = sb ^ (((sb >> 9) & 1) << 5); R = (st >> 1) * 16 + swz / 64; C = (st & 1) * 32 + (swz % 64) / 2; }
DI int perm32(int rho) { const int n = rho >> 4, i = rho & 15; return 8 * (i >> 2) + 4 * n + (i & 3); }
struct Unit { const char* a; const char* b; int kind, pm, pn, nt, ks; };
struct GemmK { int K, lda, ldb; };

template <class Epi, class Sched>
DI void gemm_phase(LAS unsigned char* lds, const GemmK g, const Sched& S, const Epi& E, const int tid_o) {
    const int tid = tid_o, wid = __builtin_amdgcn_readfirstlane(tid >> 6), lane = tid & 63, wr = wid >> 2, wc = wid & 3, fr = lane & 15, fq = lane >> 4;
    unsigned voffA[2], voffB[2];
#pragma unroll
    for (int i = 0; i < 2; ++i) { int R, C; stage_rc(tid * 16 + i * 8192, R, C); const int Rb = Epi::PERM ? ((R & ~31) + perm32(R & 31)) : R;
        voffA[i] = (unsigned)(R * g.lda + C) * 2u; voffB[i] = (unsigned)(Rb * g.ldb + C) * 2u; }
    const size_t kstep = (size_t)(BK * 2);
    const size_t hstepA = (size_t)HALF * g.lda * 2, hstepB = (size_t)HALF * g.ldb * 2;
    const unsigned ldsw = (unsigned)wid * 1024u;
    const int aoff = lds_byte(wr * 64 + fr, fq * 8), boff = lds_byte(wc * 32 + fr, fq * 8);
#define PG8_SA(b, h) (((b) * 2 + (h)) * HTB)
#define PG8_SB(b, h) ((4 + (b) * 2 + (h)) * HTB)
#define PG8_STAGE(bufoff, gbase, voff) do { _Pragma("unroll") for (int _i = 0; _i < 2; ++_i) \
        __builtin_amdgcn_global_load_lds((const unsigned*)((const char*)(gbase) + (voff)[_i]), (LAS unsigned*)(lds + (bufoff) + ldsw + _i * 8192), 16, 0, 0); } while (0)
#define PG8_LDA(dst, b, h) do { _Pragma("unroll") for (int m = 0; m < 4; ++m) _Pragma("unroll") for (int k = 0; k < 2; ++k) dst[m][k] = *(const LAS bf16x8*)(lds + PG8_SA(b, h) + aoff + m * 2048 + k * 1024); } while (0)
#define PG8_LDB(dst, b, h) do { _Pragma("unroll") for (int n = 0; n < 2; ++n) _Pragma("unroll") for (int k = 0; k < 2; ++k) dst[n][k] = *(const LAS bf16x8*)(lds + PG8_SB(b, h) + boff + n * 2048 + k * 1024); } while (0)
#define PG8_MMA(ai, bj, At, Bt) do { __builtin_amdgcn_s_setprio(1); _Pragma("unroll") for (int m = 0; m < 4; ++m) _Pragma("unroll") for (int n = 0; n < 2; ++n) _Pragma("unroll") for (int k = 0; k < 2; ++k) \
        acc[ai][bj][m][n] = __builtin_amdgcn_mfma_f32_16x16x32_bf16(Bt[n][k], At[m][k], acc[ai][bj][m][n], 0, 0, 0); __builtin_amdgcn_s_setprio(0); } while (0)
#define PG8_WAIT_V(n) asm volatile("s_waitcnt vmcnt(" #n ")" ::: "memory")
#define PG8_WAIT_L(n) asm volatile("s_waitcnt lgkmcnt(" #n ")" ::: "memory")
#define PG8_BAR __builtin_amdgcn_s_barrier()
#define PG8_SCHED __builtin_amdgcn_sched_barrier(0)
    Unit cur, nxt; int ui = 0;
    if (!S.next(0, cur)) return;
    f32x4 acc[2][2][4][2];
#pragma unroll
    for (int a = 0; a < 2; ++a)
#pragma unroll
        for (int b = 0; b < 2; ++b)
#pragma unroll
            for (int m = 0; m < 4; ++m)
#pragma unroll
                for (int n = 0; n < 2; ++n) acc[a][b][m][n] = (f32x4){0.f, 0.f, 0.f, 0.f};
    bf16x8 At[4][2], B0[2][2], B1[2][2];
    const char* cA = cur.a; const char* cB = cur.b;
    PG8_STAGE(PG8_SB(0, 0), cB, voffB); PG8_STAGE(PG8_SA(0, 0), cA, voffA); PG8_STAGE(PG8_SB(0, 1), cB + hstepB, voffB); PG8_STAGE(PG8_SA(0, 1), cA + hstepA, voffA);
    if (wr == 1) PG8_BAR;
    PG8_WAIT_V(4); PG8_BAR;
    PG8_STAGE(PG8_SB(1, 0), cB + kstep, voffB); PG8_STAGE(PG8_SA(1, 0), cA + kstep, voffA); PG8_STAGE(PG8_SB(1, 1), cB + hstepB + kstep, voffB);
    PG8_WAIT_V(6); PG8_BAR;
    for (;;) {
        const bool has_next = S.next(ui + 1, nxt);
        const char* nA = has_next ? nxt.a : cA; const char* nB = has_next ? nxt.b : cB;
        const int nt = cur.nt;
        for (int t = 0; t < nt; t += 2) {
            const bool last = (t == nt - 2);
            const char* a1 = cA + (size_t)(t + 1) * kstep;
            const char* a2 = last ? nA : cA + (size_t)(t + 2) * kstep; const char* b2 = last ? nB : cB + (size_t)(t + 2) * kstep;
            const char* a3 = a2 + kstep; const char* b3 = b2 + kstep;
            PG8_LDB(B0, 0, 0); PG8_SCHED; PG8_LDA(At, 0, 0); PG8_STAGE(PG8_SA(1, 1), a1 + hstepA, voffA);
            PG8_WAIT_L(8); PG8_BAR; PG8_WAIT_L(0); PG8_MMA(0, 0, At, B0); PG8_BAR; PG8_SCHED;
            PG8_LDB(B1, 0, 1); PG8_STAGE(PG8_SB(0, 0), b2, voffB);
            PG8_BAR; PG8_WAIT_L(0); PG8_MMA(0, 1, At, B1); PG8_BAR;
            PG8_LDA(At, 0, 1); PG8_STAGE(PG8_SA(0, 0), a2, voffA);
            PG8_BAR; PG8_WAIT_L(0); PG8_MMA(1, 0, At, B0); PG8_BAR; PG8_SCHED;
            PG8_STAGE(PG8_SB(0, 1), b2 + hstepB, voffB);
            PG8_WAIT_V(6); PG8_BAR; PG8_MMA(1, 1, At, B1); PG8_BAR;
            PG8_LDB(B0, 1, 0); PG8_SCHED; PG8_LDA(At, 1, 0); PG8_STAGE(PG8_SA(0, 1), a2 + hstepA, voffA);
            PG8_WAIT_L(8); PG8_BAR; PG8_WAIT_L(0); PG8_MMA(0, 0, At, B0); PG8_BAR; PG8_SCHED;
            PG8_LDB(B1, 1, 1); PG8_STAGE(PG8_SB(1, 0), b3, voffB);
            PG8_BAR; PG8_WAIT_L(0); PG8_MMA(0, 1, At, B1); PG8_BAR;
            PG8_LDA(At, 1, 1); PG8_STAGE(PG8_SA(1, 0), a3, voffA);
            PG8_BAR; PG8_WAIT_L(0); PG8_MMA(1, 0, At, B0); PG8_BAR; PG8_SCHED;
            PG8_STAGE(PG8_SB(1, 1), b3 + hstepB, voffB);
            PG8_WAIT_V(6); PG8_BAR; PG8_MMA(1, 1, At, B1); PG8_BAR;
        }
        E(acc, cur, wr, wc, fr, fq);
        if (!has_next) break;
#pragma unroll
        for (int a = 0; a < 2; ++a)
#pragma unroll
            for (int b = 0; b < 2; ++b)
#pragma unroll
                for (int m = 0; m < 4; ++m)
#pragma unroll
                    for (int n = 0; n < 2; ++n) acc[a][b][m][n] = (f32x4){0.f, 0.f, 0.f, 0.f};
        cur = nxt; cA = nA; cB = nB; ++ui;
    }
    PG8_WAIT_V(0);
    if (wr == 0) PG8_BAR;
    PG8_BAR;
#undef PG8_SA
#undef PG8_SB
#undef PG8_STAGE
#undef PG8_LDA
#undef PG8_LDB
#undef PG8_MMA
#undef PG8_WAIT_V
#undef PG8_WAIT_L
#undef PG8_BAR
#undef PG8_SCHED
}
}
using pg8::Unit;

DI int unit_index(int i, int G, int c) { return G == 256 ? ((i * 8 + (c & 7)) * 32 + (c >> 3)) : (i * G + c); }
DI void band_decode(int U, int nM, int nN, int& pm, int& pn) { const int band = U / (4 * nN), rem = U - band * 4 * nN; const int rows = (nM - 4 * band) < 4 ? (nM - 4 * band) : 4; pn = rem / rows; pm = 4 * band + (rem - pn * rows); }
struct SchedIn {
    const char* H; const char* W; int G, c, base, limit;
    DI bool next(int i, Unit& u) const {
        const int L = base + unit_index(i, G, c); if (L >= limit) return false;
        if (L < 693) { int pm, j; band_decode(L, 33, 21, pm, j); const int pn = j < 8 ? j : j + 4; u.kind = 0; u.nt = DM / 64; u.pm = pm; u.pn = pn; u.a = H + (size_t)pm * 256 * DM * 2; u.b = W + (size_t)pn * 256 * DM * 2; }
        else { const int r = L - 693, i4 = r & 3, j = r >> 2; u.kind = 1; u.nt = DM / 64; u.pm = i4; u.pn = j; u.a = W + (size_t)(2048 + 256 * i4) * DM * 2; u.b = H + (size_t)j * 256 * DM * 2; }
        return true;
    }
};
struct SchedPlain { const char* A; const char* B; int G, c, nM, nN, total, ntK, nfull; size_t astep, bstep;
    DI bool next(int i, Unit& u) const {
        const int L = unit_index(i, G, c); if (L >= total) return false;
        if (L < nfull) { int pm, pn; band_decode(L, nM, nN, pm, pn); u.kind = 0; u.nt = ntK; u.pm = pm; u.pn = pn; u.a = A + (size_t)pm * astep; u.b = B + (size_t)pn * bstep; }
        else { const int s = L - nfull, pn = s % nN, ks = s / nN; u.kind = 2; u.nt = 4; u.pm = 32; u.pn = pn; u.ks = ks; u.a = A + (size_t)32 * astep + (size_t)ks * 512; u.b = B + (size_t)pn * bstep + (size_t)ks * 512; }
        return true;
    }
};
struct EpiIn { static constexpr bool PERM = true; bf16_t* QK; bf16_t* VT; bf16_t* ZR;
    DI void operator()(const f32x4 (&acc)[2][2][4][2], const Unit& u, int wr, int wc, int fr, int fq) const {
        bf16_t* base; int ldc, colt; const int rowt = u.pm * 256;
        if (u.kind == 0) { if (u.pn < 8) { base = QK; ldc = 2048; colt = u.pn * 256; } else { base = ZR; ldc = DSH; colt = (u.pn - 12) * 256; } }
        else { base = VT; ldc = MPAD; colt = u.pn * 256; }
        const int row0 = rowt + wr * 64 + fr, col0 = colt + wc * 32 + 8 * fq;
#pragma unroll
        for (int ai = 0; ai < 2; ++ai)
#pragma unroll
            for (int m = 0; m < 4; ++m) { bf16_t* rowp = base + (size_t)(row0 + ai * 128 + m * 16) * ldc + col0;
#pragma unroll
                for (int bj = 0; bj < 2; ++bj) { const f32x4 v0 = acc[ai][bj][m][0], v1 = acc[ai][bj][m][1];
                    u32x4 o; o.x = pk2(v0[0], v0[1]); o.y = pk2(v0[2], v0[3]); o.z = pk2(v1[0], v1[1]); o.w = pk2(v1[2], v1[3]);
                    *(u32x4*)(rowp + bj * 128) = o; } }
    }
};
struct EpiUp { static constexpr bool PERM = true; bf16_t* GV;
    DI void operator()(const f32x4 (&acc)[2][2][4][2], const Unit& u, int wr, int wc, int fr, int fq) const {
        const int row0 = u.pm * 256 + wr * 64 + fr, col0 = u.pn * 256 + wc * 32 + 8 * fq;
#pragma unroll
        for (int ai = 0; ai < 2; ++ai)
#pragma unroll
            for (int m = 0; m < 4; ++m) { bf16_t* rowp = GV + (size_t)(row0 + ai * 128 + m * 16) * (2 * DFF) + col0;
#pragma unroll
                for (int bj = 0; bj < 2; ++bj) { const f32x4 v0 = acc[ai][bj][m][0], v1 = acc[ai][bj][m][1];
                    u32x4 o; o.x = pk2(v0[0], v0[1]); o.y = pk2(v0[2], v0[3]); o.z = pk2(v1[0], v1[1]); o.w = pk2(v1[2], v1[3]);
                    *(u32x4*)(rowp + bj * 128) = o; } }
    }
};
struct EpiNull { static constexpr bool PERM = false; float* sink;
    DI void operator()(const f32x4 (&acc)[2][2][4][2], const Unit& u, int wr, int wc, int fr, int fq) const { if (acc[0][0][0][0][0] == 123456.789f) sink[0] = 1.f; }
};
template <bool RMW> struct EpiRes { static constexpr bool PERM = false; float* out; const float* xp; const float* xs; const float* MOD; int goff; float* slab;
    DI void operator()(const f32x4 (&acc)[2][2][4][2], const Unit& u, int wr, int wc, int fr, int fq) const {
        const int row0 = u.pm * 256 + wr * 64 + fr, col0 = u.pn * 256 + wc * 32 + 4 * fq;
#pragma unroll
        for (int ai = 0; ai < 2; ++ai)
#pragma unroll
            for (int m = 0; m < 4; ++m) { const int row = row0 + ai * 128 + m * 16;
                if (row < MT) {
                    const int b = row < MPR ? (row >> 11) : 4 + ((row - MPR) >> 4);
                    const float* gp = MOD + (size_t)b * NMOD + goff + col0;
                    float* op = out + (size_t)row * DM + col0;
                    const float* xr = RMW ? op : (row < MPR ? xp + (size_t)row * DM + col0 : xs + (size_t)(row - MPR) * DM + col0);
#pragma unroll
                    for (int bj = 0; bj < 2; ++bj)
#pragma unroll
                        for (int n = 0; n < 2; ++n) { const int o = bj * 128 + n * 16;
                            const f32x4 gv = *(const f32x4*)(gp + o); const f32x4 xv = __builtin_nontemporal_load((const f32x4*)(xr + o));
                            if (u.kind == 2) *(f32x4*)(slab + ((size_t)u.ks * MS + (row - MPR)) * DM + col0 + o) = acc[ai][bj][m][n];
                            else if (RMW) __builtin_nontemporal_store(xv + gv * acc[ai][bj][m][n], (f32x4*)(op + o));
                            else *(f32x4*)(op + o) = xv + gv * acc[ai][bj][m][n]; } } }
    }
};

DI void transpose_item(const float* W, int N, bf16_t* WT, int ldt, int coloff, LAS float* scr, int item, int lane) {
    const int nblk = N / 32, kb = item / nblk, nb = item % nblk, k0 = 64 * kb, n0 = 32 * nb;
#pragma unroll 8
    for (int i = 0; i < 32; ++i) { const int kk = 2 * i + (lane >> 5); scr[kk * 33 + (lane & 31)] = __builtin_nontemporal_load(W + (size_t)(k0 + kk) * N + n0 + (lane & 31)); }
    asm volatile("s_waitcnt lgkmcnt(0)" ::: "memory");
    const int c = lane & 7;
#pragma unroll
    for (int j = 0; j < 4; ++j) { const int n = (lane >> 3) + 8 * j; const LAS float* s = scr + (8 * c) * 33 + n;
        u32x4 o; o.x = pk2(s[0 * 33], s[1 * 33]); o.y = pk2(s[2 * 33], s[3 * 33]); o.z = pk2(s[4 * 33], s[5 * 33]); o.w = pk2(s[6 * 33], s[7 * 33]);
        *(u32x4*)(WT + (size_t)(n0 + n) * ldt + coloff + k0 + 8 * c) = o; }
    asm volatile("s_waitcnt lgkmcnt(0)" ::: "memory");
}
DI void phase0(const Params& p, LAS unsigned char* lds, const int tid_o) {
    const int tid = tid_o, wave = tid >> 6, lane = tid & 63, blk = blockIdx.x, G = gridDim.x;
    unsigned char* ws = p.ws;
    if (blk == 0 && tid < 64) ((unsigned*)(ws + WS_CTR))[64 + tid] = 0u;
    LAS float* sc = (LAS float*)lds;
    LAS float* red = (LAS float*)(lds + 12288);
    float* MODP = (float*)(ws + WS_MODP);
    const float* w_ada = p.in[I_WADA];
    for (int tile = blk; tile < 384; tile += G) {
        const int ct = tile % 48, kc = tile / 48;
        __syncthreads();
        for (int i = tid; i < 3072; i += 512) { const int r = i >> 8, kk = i & 255;
            const float cv = r < 4 ? p.in[I_CP][r * DM + kc * 256 + kk] : p.in[I_CS][(r - 4) * DM + kc * 256 + kk];
            sc[i] = cv / (1.f + __expf(-cv)); }
        __syncthreads();
        f32x4 acc[12];
#pragma unroll
        for (int r = 0; r < 12; ++r) acc[r] = (f32x4){0.f, 0.f, 0.f, 0.f};
        const float* wp = w_ada + (size_t)(kc * 256 + wave * 32) * NMOD + ct * 256 + lane * 4;
#pragma unroll 4
        for (int k = 0; k < 32; ++k) { const f32x4 wv = __builtin_nontemporal_load((const f32x4*)(wp + (size_t)k * NMOD));
#pragma unroll
            for (int r = 0; r < 12; ++r) acc[r] += sc[r * 256 + wave * 32 + k] * wv; }
#pragma unroll
        for (int r = 0; r < 12; ++r) *(LAS f32x4*)(red + (wave * 12 + r) * 256 + lane * 4) = acc[r];
        __syncthreads();
        for (int i = tid; i < 3072; i += 512) { const int r = i >> 8, cc = i & 255; float s = 0.f;
#pragma unroll
            for (int w = 0; w < 8; ++w) s += red[(w * 12 + r) * 256 + cc];
            MODP[(size_t)(kc * 12 + r) * NMOD + ct * 256 + cc] = s; }
    }
    __syncthreads();
    LAS float* scr = (LAS float*)(lds + wave * 16384);
    const int gw = blk * 8 + wave, NGW = G * 8;
    constexpr int I_IN = 32 * 200, I_OUT = 32 * 64, I_UP = 32 * 352, I_DN = 88 * 64, I_L = 32;
    constexpr int NITEMS = I_IN + I_OUT + I_UP + I_DN + 4 * I_L;
    for (int it = gw; it < NITEMS; it += NGW) {
        int r = it;
        if (r < I_IN) { transpose_item(p.in[I_WIN], DIN, (bf16_t*)(ws + WS_WT_IN), DM, 0, scr, r, lane); continue; } r -= I_IN;
        if (r < I_OUT) { transpose_item(p.in[I_WOUT], DM, (bf16_t*)(ws + WS_WT_OUT), DM, 0, scr, r, lane); continue; } r -= I_OUT;
        if (r < I_UP) { transpose_item(p.in[I_WUP], 2 * DFF, (bf16_t*)(ws + WS_WT_UP), DM, 0, scr, r, lane); continue; } r -= I_UP;
        if (r < I_DN) { transpose_item(p.in[I_WDN], DM, (bf16_t*)(ws + WS_WT_DOWN), DFF, 0, scr, r, lane); continue; } r -= I_DN;
        if (r < I_L) { transpose_item(p.in[I_W2], 1024, (bf16_t*)(ws + WS_LT), 256, 0, scr, r, lane); continue; } r -= I_L;
        if (r < I_L) { transpose_item(p.in[I_A2], 1024, (bf16_t*)(ws + WS_LT), 256, 64, scr, r, lane); continue; } r -= I_L;
        transpose_item(p.in[I_G2], 1024, (bf16_t*)(ws + WS_LT), 256, 128, scr, r, lane);
    }
}

DI void deferred_convert(const Params& p, LAS unsigned char* lds, const int tid_o) {
    const int wave = __builtin_amdgcn_readfirstlane(tid_o >> 6), lane = tid_o & 63;
    unsigned char* ws = p.ws; unsigned* ctr = (unsigned*)(ws + WS_CTR) + 64;
    LAS float* scr = (LAS float*)(lds + wave * 16384);
    constexpr int I_OUT = 32 * 64, I_UP = 32 * 352, I_DN = 88 * 64;
    for (;;) { unsigned t = 0; if (lane == 0) t = atomicAdd(ctr, 1u); int r = (int)__builtin_amdgcn_readfirstlane(t); if (r >= I_OUT + I_UP + I_DN) break;
        if (r < I_OUT) { transpose_item(p.in[I_WOUT], DM, (bf16_t*)(ws + WS_WT_OUT), DM, 0, scr, r, lane); continue; } r -= I_OUT;
        if (r < I_UP) { transpose_item(p.in[I_WUP], 2 * DFF, (bf16_t*)(ws + WS_WT_UP), DM, 0, scr, r, lane); continue; } r -= I_UP;
        transpose_item(p.in[I_WDN], DM, (bf16_t*)(ws + WS_WT_DOWN), DFF, 0, scr, r, lane); }
}

template <int WHICH> DI void phase_norm(const Params& p, LAS unsigned char* lds, const int tid_o) {
    const int tid = tid_o, wave = tid >> 6, lane = tid & 63, blk = blockIdx.x, G = gridDim.x;
    unsigned char* ws = p.ws;
    const float* MODP = (const float*)(ws + WS_MODP); float* MOD = (float*)(ws + WS_MOD);
    const float* b_ada = p.in[I_BADA];
    if (WHICH == 0) {
        for (int r = blk; r < 12; r += G)
            for (int j = tid; j < NMOD; j += 512) { float s = b_ada[j];
#pragma unroll
                for (int pp = 0; pp < 8; ++pp) s += MODP[(size_t)(pp * 12 + r) * NMOD + j];
                MOD[(size_t)r * NMOD + j] = s; }
    }
    LAS float* Al = (LAS float*)lds; LAS float* Bl = Al + DM;
    const float* gamma = WHICH == 0 ? p.in[I_NAG] : p.in[I_NFG];
    bf16_t* H = (bf16_t*)(ws + WS_H);
    for (int chunk = blk; chunk < 264; chunk += G) {
        const int b = chunk < 256 ? (chunk >> 6) : 4 + (chunk - 256);
        __syncthreads();
        for (int j = tid; j < DM; j += 512) { float scv, shv;
            if (WHICH == 0) { scv = b_ada[DM + j]; shv = b_ada[j];
#pragma unroll
                for (int pp = 0; pp < 8; ++pp) { scv += MODP[(size_t)(pp * 12 + b) * NMOD + DM + j]; shv += MODP[(size_t)(pp * 12 + b) * NMOD + j]; } }
            else { scv = MOD[(size_t)b * NMOD + 4 * DM + j]; shv = MOD[(size_t)b * NMOD + 3 * DM + j]; }
            Al[j] = gamma[j] * (1.f + scv); Bl[j] = shv; }
        __syncthreads();
        const int nrows = chunk < 256 ? 32 : 16, row0 = chunk < 256 ? chunk * 32 : MPR + (chunk - 256) * 16;
        if (WHICH == 1 && chunk >= 256) {
            const float* slab = (const float*)(ws + WS_FV);
            for (int i = tid; i < 16 * DM / 4; i += 512) { const int r = i >> 9, c4 = (i & 511) * 4; const int m = row0 + r; f32x4 sum = (f32x4){0.f, 0.f, 0.f, 0.f};
#pragma unroll
                for (int ks = 0; ks < 8; ++ks) sum += *(const f32x4*)(slab + ((size_t)ks * MS + (m - MPR)) * DM + c4);
                const f32x4 g = *(const f32x4*)(MOD + (size_t)b * NMOD + 2 * DM + c4); f32x4* op = (f32x4*)(p.out + (size_t)m * DM + c4); *op = *op + g * sum; }
            __syncthreads();
        }
        const int nr = nrows >> 3;
        for (int rp = 0; rp < nr; rp += 2) {
            f32x4 v[2][8]; float ss[2] = {0.f, 0.f};
#pragma unroll
            for (int q = 0; q < 2; ++q) { const int m = row0 + wave + 8 * (rp + q);
                const float* xr = WHICH == 0 ? (m < MPR ? p.in[I_XP] + (size_t)m * DM : p.in[I_XS] + (size_t)(m - MPR) * DM) : p.out + (size_t)m * DM;
#pragma unroll
                for (int j = 0; j < 8; ++j) v[q][j] = __builtin_nontemporal_load((const f32x4*)(xr + j * 256 + lane * 4)); }
#pragma unroll
            for (int q = 0; q < 2; ++q) {
#pragma unroll
                for (int j = 0; j < 8; ++j) ss[q] += v[q][j].x * v[q][j].x + v[q][j].y * v[q][j].y + v[q][j].z * v[q][j].z + v[q][j].w * v[q][j].w; }
#pragma unroll
            for (int q = 0; q < 2; ++q) { const int m = row0 + wave + 8 * (rp + q);
                const float rstd = rsqrtf(wave_sum(ss[q]) * (1.f / DM) + 1e-6f);
#pragma unroll
                for (int j = 0; j < 8; ++j) { const int idx = j * 256 + lane * 4; const f32x4 a4 = *(const LAS f32x4*)(Al + idx), b4 = *(const LAS f32x4*)(Bl + idx);
                    const f32x4 o = v[q][j] * rstd * a4 + b4; u32x2 qq; qq.x = pk2(o.x, o.y); qq.y = pk2(o.z, o.w);
                    *(u32x2*)(H + (size_t)m * DM + idx) = qq; } }
        }
    }
}

DI void load_zs(const Params& p, const bf16_t* ZR, int m, int c, int n, float* o) {
    const bool samp = m >= MPR; const int t = samp ? ((m - MPR) & 15) : (m & (SEQ - 1)); const int bs = samp ? ((m - MPR) >> 4) : 0;
    const int mp = t > 0 ? m - 1 : m;
    float z[8], zp[8], st[8];
    if (n == 8) { unpack8(*(const u32x4*)(ZR + (size_t)m * DSH + c), z); unpack8(*(const u32x4*)(ZR + (size_t)mp * DSH + c), zp);
        const f32x4 s0 = *(const f32x4*)(p.in[I_SS] + (size_t)bs * DSH + c), s1 = *(const f32x4*)(p.in[I_SS] + (size_t)bs * DSH + c + 4);
        st[0] = s0.x; st[1] = s0.y; st[2] = s0.z; st[3] = s0.w; st[4] = s1.x; st[5] = s1.y; st[6] = s1.z; st[7] = s1.w; }
    else { unpack4(*(const u32x2*)(ZR + (size_t)m * DSH + c), z); unpack4(*(const u32x2*)(ZR + (size_t)mp * DSH + c), zp);
        const f32x4 s0 = *(const f32x4*)(p.in[I_SS] + (size_t)bs * DSH + c); st[0] = s0.x; st[1] = s0.y; st[2] = s0.z; st[3] = s0.w; }
    const float* mu = p.in[I_MU] + c;
#pragma unroll
    for (int j = 0; j < n; ++j) { const float pv = t > 0 ? zp[j] : (samp ? st[j] : 0.f); o[j] = z[j] + (pv - z[j]) * mu[j]; }
}
DI void phase_prep(const Params& p, LAS unsigned char* lds, const int tid_o) {
    const int tid = tid_o, wave = tid >> 6, lane = tid & 63, blk = blockIdx.x, G = gridDim.x;
    unsigned char* ws = p.ws; float* out = p.out;
    bf16_t* QK = (bf16_t*)(ws + WS_QK); const bf16_t* VT = (const bf16_t*)(ws + WS_VT); const bf16_t* ZR = (const bf16_t*)(ws + WS_ZR);
    const int gw = blk * 8 + wave, NGW = G * 8;
    if (blk == 0 && tid >= 128 && tid < 256) ((unsigned*)(ws + WS_CTR))[tid] = 0u;
    if (G == 256) {
        SchedIn S; S.H = (const char*)(ws + WS_H); S.W = (const char*)(ws + WS_WT_IN); S.G = G; S.c = blk; S.base = 768; S.limit = 825;
        EpiIn E; E.QK = (bf16_t*)(ws + WS_QK); E.VT = (bf16_t*)(ws + WS_VT); E.ZR = (bf16_t*)(ws + WS_ZR);
        pg8::gemm_phase(lds, pg8::GemmK{DM, DM, DM}, S, E, tid_o);
        __syncthreads();
    }
    for (int m = gw; m < MT; m += NGW) {
        int lane_o = lane; asm volatile("" : "+v"(lane_o));
#pragma unroll
        for (int it = 0; it < 4; ++it) { const int col = it * 512 + lane_o * 8;
            float x[8]; unpack8(*(const u32x4*)(QK + (size_t)m * 2048 + col), x);
            float ss = 0.f;
#pragma unroll
            for (int j = 0; j < 8; ++j) ss += x[j] * x[j];
            ss += __shfl_xor(ss, 1); ss += __shfl_xor(ss, 2); ss += __shfl_xor(ss, 4);
            const float rstd = rsqrtf(ss * (1.f / 64.f) + 1e-6f);
            const bool isk = col >= 1024; const float* g = (isk ? p.in[I_KG] : p.in[I_QG]) + (col & 63);
            float y[8];
#pragma unroll
            for (int j = 0; j < 8; ++j) y[j] = x[j] * rstd * g[j];
            if (isk) {
                const int hc = col - 1024;
                float* op = nullptr;
                if (m >= MPR) op = out + O_KS + (size_t)(m - MPR) * 1024 + hc;
                else { const int t = m & (SEQ - 1), b = m >> 11; if (t >= SEQ - 512) op = out + O_KP + ((size_t)b * 512 + (t - (SEQ - 512))) * 1024 + hc; }
                if (op) { *(f32x4*)op = (f32x4){y[0], y[1], y[2], y[3]}; *(f32x4*)(op + 4) = (f32x4){y[4], y[5], y[6], y[7]}; }
            } else {
#pragma unroll
                for (int j = 0; j < 8; ++j) y[j] *= 0.125f;
            }
            u32x4 o; o.x = pk2(y[0], y[1]); o.y = pk2(y[2], y[3]); o.z = pk2(y[4], y[5]); o.w = pk2(y[6], y[7]);
            *(u32x4*)(QK + (size_t)m * 2048 + col) = o; }
    }
#if REPEAT_SUB == 3
    for (int rep3 = 0; rep3 < 2; ++rep3) {
#else
    {
#endif
    { bf16_t* KC = (bf16_t*)(ws + WS_KC); bf16_t* VTC = (bf16_t*)(ws + WS_VTC);
      for (int i = blk * 512 + tid; i < 8 * 512 * 1024 / 8; i += G * 512) { const f32x4 a0 = __builtin_nontemporal_load((const f32x4*)(p.in[I_CK] + (size_t)i * 8)), a1 = __builtin_nontemporal_load((const f32x4*)(p.in[I_CK] + (size_t)i * 8 + 4));
          u32x4 o; o.x = pk2(a0.x, a0.y); o.y = pk2(a0.z, a0.w); o.z = pk2(a1.x, a1.y); o.w = pk2(a1.z, a1.w); *(u32x4*)(KC + (size_t)i * 8) = o; }
      for (int task = gw; task < 8 * 16 * 8; task += NGW) { const int jb = task & 7, cb = (task >> 3) & 15, b = task >> 7; const int c = cb * 64 + lane;
          float v[64];
#pragma unroll
          for (int j = 0; j < 64; ++j) v[j] = __builtin_nontemporal_load(p.in[I_CV] + ((size_t)b * 512 + jb * 64 + j) * 1024 + c);
#pragma unroll
          for (int q = 0; q < 8; ++q) { u32x4 o; o.x = pk2(v[8 * q], v[8 * q + 1]); o.y = pk2(v[8 * q + 2], v[8 * q + 3]); o.z = pk2(v[8 * q + 4], v[8 * q + 5]); o.w = pk2(v[8 * q + 6], v[8 * q + 7]);
              *(u32x4*)(VTC + ((size_t)b * 1024 + c) * 512 + jb * 64 + 8 * q) = o; } }
    }
    { const size_t gt = (size_t)blk * 512 + tid, NT = (size_t)G * 512;
      for (size_t i = gt; i < (size_t)12 * DSH; i += NT) { const int r = (int)(i / DSH), c = (int)(i % DSH);
          if (r < 4) out[O_SHP + (size_t)r * DSH + c] = bf1(ZR[(size_t)(r * SEQ + SEQ - 1) * DSH + c]);
          else out[O_SHS + (size_t)(r - 4) * DSH + c] = bf1(ZR[(size_t)(MPR + (r - 4) * 16 + 15) * DSH + c]); }
    }
    const bf16_t* LT = (const bf16_t*)(ws + WS_LT);
    float* FW = (float*)(ws + WS_FW); bf16_t* FB = (bf16_t*)(ws + WS_FB); bf16_t* FV = (bf16_t*)(ws + WS_FV); bf16_t* GG = (bf16_t*)(ws + WS_GG); float* BON = (float*)(ws + WS_BONUS);
    const float* SSH = p.in[I_SS]; const float* MU = p.in[I_MU];
    LAS unsigned char* Ap = lds;
    LAS bf16_t* zt = (LAS bf16_t*)(lds + 16896 + wave * 13200);
    const int n0 = lane & 31, hf0 = lane >> 5;
    for (;;) {
        LAS int* tslot = (LAS int*)(lds + 130944);
        __syncthreads();
        if (tid == 0) *tslot = (int)atomicAdd((unsigned*)(ws + WS_CTR) + 64, 1u);
        __syncthreads();
        const int task = *tslot; if (task >= 520) break;
        const int m0 = (task >> 1) * 32; const bool samp = m0 >= MPR;
        int hf = hf0; asm volatile("" : "+v"(hf));
        __syncthreads();
        {
            const int tk = tid >> 4, cc = (tid & 15) * 16; const int m = m0 + tk;
            const int t = samp ? ((m - MPR) & 15) : (m & (SEQ - 1)); const int bs = samp ? ((m - MPR) >> 4) : 0; const int mp = t > 0 ? m - 1 : m;
            float z[16], zp[16];
            unpack8(*(const u32x4*)(ZR + (size_t)m * DSH + 3072 + cc), z); unpack8(*(const u32x4*)(ZR + (size_t)m * DSH + 3072 + cc + 8), z + 8);
            unpack8(*(const u32x4*)(ZR + (size_t)mp * DSH + 3072 + cc), zp); unpack8(*(const u32x4*)(ZR + (size_t)mp * DSH + 3072 + cc + 8), zp + 8);
            float o[16];
#pragma unroll
            for (int j4 = 0; j4 < 4; ++j4) { const f32x4 mu4 = *(const f32x4*)(MU + 3072 + cc + 4 * j4), st4 = *(const f32x4*)(SSH + (size_t)bs * DSH + 3072 + cc + 4 * j4);
#pragma unroll
                for (int e = 0; e < 4; ++e) { const int j = 4 * j4 + e; const float pv = t > 0 ? zp[j] : (samp ? st4[e] : 0.f); float v = z[j] + (pv - z[j]) * mu4[e];
                    if (cc < 64) v = 1.f - 2.f / (1.f + __expf(2.f * v)); else if (cc >= 128) v = sigmoidf_(v);
                    o[j] = v; } }
            u32x4 q0, q1; q0.x = pk2(o[0], o[1]); q0.y = pk2(o[2], o[3]); q0.z = pk2(o[4], o[5]); q0.w = pk2(o[6], o[7]); q1.x = pk2(o[8], o[9]); q1.y = pk2(o[10], o[11]); q1.z = pk2(o[12], o[13]); q1.w = pk2(o[14], o[15]);
            *(LAS u32x4*)(Ap + tk * 528 + cc * 2) = q0; *(LAS u32x4*)(Ap + tk * 528 + cc * 2 + 16) = q1;
        }
        __syncthreads();
        bf16x8 Bf[16];
#pragma unroll
        for (int s = 0; s < 16; ++s) Bf[s] = *(const LAS bf16x8*)(Ap + n0 * 528 + (16 * s + 8 * hf) * 2);
#pragma unroll 1
        for (int hh = (task & 1); hh <= (task & 1); ++hh) { const int h = wave * 2 + hh;
            int n = n0; asm volatile("" : "+v"(hf), "+v"(n));
            for (int q = lane; q < 33 * 24; q += 64) { const int row = q / 24, seg = q - row * 24, vec = seg >> 3, part = seg & 7; int mr = m0 - 1 + row; mr = mr < 0 ? 0 : mr;
                *(LAS u32x4*)(zt + row * 200 + vec * 64 + part * 8) = *(const u32x4*)(ZR + (size_t)mr * DSH + vec * 1024 + h * 64 + part * 8); }
#pragma unroll 1
            for (int b2 = 0; b2 < 2; ++b2) { f32x16 ag; for (int i = 0; i < 16; ++i) ag[i] = 0.f;
                const int c = h * 64 + b2 * 32 + n; const bf16_t* lt = LT + (size_t)c * 256 + 8 * hf;
#pragma unroll
                for (int s = 8; s < 16; ++s) ag = MFMA32(Bf[s], *(const bf16x8*)(lt + 16 * s), ag);
#pragma unroll
                for (int i = 0; i < 16; ++i) GG[(size_t)(m0 + crow(i, hf)) * 1024 + c] = (bf16_t)(pk2(ag[i], 0.f) & 0xffffu); }
#define ZS(vec, cl, i, muv, stv) ({ const int ti_ = crow(i, hf); const float z_ = bf1(zt[(ti_ + 1) * 200 + (vec) * 64 + (cl)]); float pv_ = bf1(zt[ti_ * 200 + (vec) * 64 + (cl)]); \
                if ((i) == 0 || (i) == 8) { const int m_ = m0 + ti_; const int t_ = samp ? ((m_ - MPR) & 15) : (m_ & (SEQ - 1)); if (t_ == 0) pv_ = samp ? (stv) : 0.f; } z_ + (pv_ - z_) * (muv); })
            float ssq[16];
#pragma unroll
            for (int i = 0; i < 16; ++i) ssq[i] = 0.f;
#pragma unroll
            for (int b2 = 0; b2 < 2; ++b2) { const int cl = b2 * 32 + n, c = h * 64 + cl; const float kkw = p.in[I_KK][c], muk = MU[1024 + c];
                const int bs0 = samp ? ((m0 - MPR) >> 4) : 0; const float st0 = SSH[(size_t)bs0 * DSH + 1024 + c], st1 = SSH[(size_t)(samp ? bs0 + 1 : 0) * DSH + 1024 + c];
#pragma unroll
                for (int i = 0; i < 16; ++i) { const float kv = ZS(1, cl, i, muk, (i == 0 ? st0 : st1)); const float q = kv * kkw; ssq[i] += q * q; } }
            float inv[16];
#pragma unroll
            for (int i = 0; i < 16; ++i) { float v = row16_sum(ssq[i]); v += __shfl_xor(v, 16); inv[i] = 1.f / fmaxf(sqrtf(v), 1e-12f); }
            float bon[16];
#pragma unroll
            for (int i = 0; i < 16; ++i) bon[i] = 0.f;
#pragma unroll 1
            for (int b2 = 0; b2 < 2; ++b2) { asm volatile("" : "+v"(hf), "+v"(n)); const int cl = b2 * 32 + n, c = h * 64 + cl;
                f32x16 aw, aa; for (int i = 0; i < 16; ++i) { aw[i] = 0.f; aa[i] = 0.f; }
                const bf16_t* lt = LT + (size_t)c * 256 + 8 * hf;
#pragma unroll
                for (int s = 0; s < 4; ++s) aw = MFMA32(Bf[s], *(const bf16x8*)(lt + 16 * s), aw);
#pragma unroll
                for (int s = 4; s < 8; ++s) aa = MFMA32(Bf[s], *(const bf16x8*)(lt + 16 * s), aa);
                const float w0 = p.in[I_W0][c], a0 = p.in[I_A0][c], kkw = p.in[I_KK][c], kaw = p.in[I_KA][c], rkw = p.in[I_RK][c], mur = MU[c], muk = MU[1024 + c], muv = MU[2048 + c];
                const int bs0 = samp ? ((m0 - MPR) >> 4) : 0, bs1 = samp ? bs0 + 1 : 0;
                const float sr0 = SSH[(size_t)bs0 * DSH + c], sr1 = SSH[(size_t)bs1 * DSH + c], sk0 = SSH[(size_t)bs0 * DSH + 1024 + c], sk1 = SSH[(size_t)bs1 * DSH + 1024 + c], sv0 = SSH[(size_t)bs0 * DSH + 2048 + c], sv1 = SSH[(size_t)bs1 * DSH + 2048 + c];
#pragma unroll
                for (int i = 0; i < 16; ++i) { const int m = m0 + crow(i, hf);
                    const float rz = ZS(0, cl, i, mur, (i == 0 ? sr0 : sr1)), kv = ZS(1, cl, i, muk, (i == 0 ? sk0 : sk1)), vz = ZS(2, cl, i, muv, (i == 0 ? sv0 : sv1));
                    const float wl = w0 + aw[i];
                    const float y = -wl; const float sp = fmaxf(y, 0.f) + __logf(1.f + __expf(-fabsf(y)));
                    const float dec = __expf(-__expf(-sp - 0.5f));
                    const float av = sigmoidf_(a0 + aa[i]);
                    const float kk = kv * kkw * inv[i], kp = kv * (1.f + (av - 1.f) * kaw), kka = kk * av;
                    bon[i] += rz * kp * rkw;
                    FW[((size_t)m * 16 + h) * 64 + cl] = dec;
                    bf16_t* fb = FB + ((size_t)m * 16 + h) * 256 + cl;
                    fb[0] = (bf16_t)(pk2(rz, 0.f) & 0xffffu); fb[64] = (bf16_t)(pk2(kp, 0.f) & 0xffffu); fb[128] = (bf16_t)(pk2(kk, 0.f) & 0xffffu); fb[192] = (bf16_t)(pk2(kka, 0.f) & 0xffffu);
                    FV[(size_t)m * 1024 + c] = (bf16_t)(pk2(vz, 0.f) & 0xffffu); __builtin_amdgcn_sched_barrier(0); }
            }
#undef ZS
#pragma unroll
            for (int i = 0; i < 16; ++i) { float v = row16_sum(bon[i]); v += __shfl_xor(v, 16); if (n == 0) BON[(size_t)(m0 + crow(i, hf)) * 16 + h] = v; }
        }
    }
    }
}

constexpr int SC_TC = 16, SC_NB = 4, SC_BUFB = SC_TC * 1280 + SC_TC * 64;
constexpr int L_FLAGS = SC_NB * SC_BUFB, L_TBL = L_FLAGS + 64, L_KV = L_TBL + 8 * 1040, KV_STRIDE = 144, KV_BYTES = 2 * 64 * KV_STRIDE;
DI void scan_run(const Params& p, LAS unsigned char* lds, const int wave, const int lane, const int blk, const int G) {
    unsigned char* ws = p.ws; float* out = p.out;
    const float* FW = (const float*)(ws + WS_FW); const bf16_t* FB = (const bf16_t*)(ws + WS_FB); const bf16_t* FV = (const bf16_t*)(ws + WS_FV); float* Y = (float*)(ws + WS_Y);
    LAS unsigned* ready = (LAS unsigned*)(lds + L_FLAGS); LAS unsigned* done = ready + SC_NB;
    unsigned gc = 0;
    for (int u = blk; u < 768; u += G) {
        int m0, T, h, rg; const float* S0; float* Sout;
        if (u < 256) { const int bh = G == 256 ? ((u & 7) * 8 + (u >> 5)) : (u >> 2); rg = G == 256 ? ((u >> 3) & 3) : (u & 3); h = bh & 15; m0 = (bh >> 4) * SEQ; T = SEQ; S0 = nullptr; Sout = out + O_SP + (size_t)bh * 4096; }
        else { const int su = u - 256, bh = G == 256 ? ((su & 7) * 16 + (su >> 5)) : (su >> 2); rg = G == 256 ? ((su >> 3) & 3) : (su & 3); h = bh & 15; m0 = MPR + (bh >> 4) * 16; T = 16; S0 = p.in[I_SR] + (size_t)bh * 4096; Sout = out + O_SS + (size_t)bh * 4096; }
        const int nch = T / SC_TC;
        if (wave >= 4) {
            const int lw = wave - 4; const int cstart = (int)((gc + (unsigned)lw) & 1u); const int nmine = (nch - cstart + 1) >> 1;
            f32x4 fw[3][4]; u32x4 fb[3][8]; u32x4 fv[3];
#define FEED_ISSUE(slot, jidx) do { const int _j = (jidx) < nmine ? (jidx) : nmine - 1; const int _mb = m0 + (cstart + 2 * _j) * SC_TC; \
                _Pragma("unroll") for (int i = 0; i < 4; ++i) { const int idx = i * 64 + lane, st = idx >> 4, q = idx & 15; fw[slot][i] = *(const f32x4*)(FW + ((size_t)(_mb + st) * 16 + h) * 64 + q * 4); } \
                _Pragma("unroll") for (int i = 0; i < 8; ++i) { const int idx = i * 64 + lane, st = idx >> 5, q = idx & 31; fb[slot][i] = *(const u32x4*)(FB + ((size_t)(_mb + st) * 16 + h) * 256 + q * 8); } \
                fv[slot] = *(const u32x4*)(FV + (size_t)(_mb + ((lane & 31) >> 1)) * 1024 + h * 64 + rg * 16 + (lane & 1) * 8); } while (0)
            if (nmine > 0) {
                FEED_ISSUE(0, 0); FEED_ISSUE(1, 1);
                for (int j0 = 0; j0 < nmine; j0 += 3) {
#pragma unroll
                    for (int jj = 0; jj < 3; ++jj) { const int j = j0 + jj;
                        if (j < nmine) {
                            FEED_ISSUE((jj + 2) % 3, j + 2);
                            const unsigned g = gc + (unsigned)(cstart + 2 * j); const int b = g & (SC_NB - 1);
                            if (g >= SC_NB) { const unsigned target = 4u * (g / SC_NB); while (__hip_atomic_load(done + b, __ATOMIC_RELAXED, __HIP_MEMORY_SCOPE_WORKGROUP) < target) __builtin_amdgcn_s_sleep(1); asm volatile("" ::: "memory"); }
                            LAS unsigned char* buf = lds + b * SC_BUFB;
#pragma unroll
                            for (int i = 0; i < 4; ++i) { const int idx = i * 64 + lane, st = idx >> 4, q = idx & 15; *(LAS f32x4*)(buf + st * 1280 + q * 16) = fw[jj][i]; }
#pragma unroll
                            for (int i = 0; i < 8; ++i) { const int idx = i * 64 + lane, st = idx >> 5, q = idx & 31; float f[8]; unpack8(fb[jj][i], f);
                                LAS float* d = (LAS float*)(buf + st * 1280 + 256 + q * 32); *(LAS f32x4*)d = (f32x4){f[0], f[1], f[2], f[3]}; *(LAS f32x4*)(d + 4) = (f32x4){f[4], f[5], f[6], f[7]}; }
                            if (lane < 32) { float f[8]; unpack8(fv[jj], f); LAS float* d = (LAS float*)(buf + SC_TC * 1280 + (lane >> 1) * 64 + (lane & 1) * 32);
                                *(LAS f32x4*)d = (f32x4){f[0], f[1], f[2], f[3]}; *(LAS f32x4*)(d + 4) = (f32x4){f[4], f[5], f[6], f[7]}; }
                            asm volatile("" ::: "memory");
                            if (lane == 0) __hip_atomic_store(ready + b, g + 1u, __ATOMIC_RELAXED, __HIP_MEMORY_SCOPE_WORKGROUP);
                            asm volatile("" ::: "memory");
                        }
                    }
                }
            }
#undef FEED_ISSUE
        } else {
            const int rl = wave * 4 + (lane >> 4), kq = lane & 15, row = rg * 16 + rl;
            f32x2 Sa = (f32x2){0.f, 0.f}, Sb = (f32x2){0.f, 0.f};
            if (S0) { const f32x4 s4 = *(const f32x4*)(S0 + row * 64 + kq * 4); Sa = (f32x2){s4.x, s4.y}; Sb = (f32x2){s4.z, s4.w}; }
            for (int c = 0; c < nch; ++c) { const unsigned g = gc + c; const int b = g & (SC_NB - 1);
                while (__hip_atomic_load(ready + b, __ATOMIC_RELAXED, __HIP_MEMORY_SCOPE_WORKGROUP) < g + 1u) __builtin_amdgcn_s_sleep(1);
                asm volatile("" ::: "memory");
                const LAS unsigned char* buf = lds + b * SC_BUFB;
                float ykeep = 0.f;
                f32x4 W_[3], R_[3], K_[3], KK_[3], KA_[3]; float V_[3];
#define SC_LOAD(slot, st) do { const LAS unsigned char* sb = buf + (st) * 1280 + kq * 16; W_[slot] = *(const LAS f32x4*)(sb); R_[slot] = *(const LAS f32x4*)(sb + 256); K_[slot] = *(const LAS f32x4*)(sb + 512); \
                    KK_[slot] = *(const LAS f32x4*)(sb + 768); KA_[slot] = *(const LAS f32x4*)(sb + 1024); V_[slot] = *(const LAS float*)(buf + SC_TC * 1280 + (st) * 64 + rl * 4); } while (0)
                SC_LOAD(0, 0); SC_LOAD(1, 1); SC_LOAD(2, 2);
#pragma unroll
                for (int st = 0; st < SC_TC; ++st) { const int sl = st % 3;
                    const f32x4 w4 = W_[sl], r4 = R_[sl], k4 = K_[sl], kk4 = KK_[sl], ka4 = KA_[sl]; const float vv = V_[sl];
                    f32x2 p2 = Sa * (f32x2){kk4.x, kk4.y}; p2 = Sb * (f32x2){kk4.z, kk4.w} + p2;
                    float pa = p2.x + p2.y; pa = row16_sum(pa);
                    const f32x2 Ta = Sa * (f32x2){w4.x, w4.y} + vv * (f32x2){k4.x, k4.y}, Tb = Sb * (f32x2){w4.z, w4.w} + vv * (f32x2){k4.z, k4.w};
                    Sa = Ta - pa * (f32x2){ka4.x, ka4.y}; Sb = Tb - pa * (f32x2){ka4.z, ka4.w};
                    f32x2 q2 = Sa * (f32x2){r4.x, r4.y}; q2 = Sb * (f32x2){r4.z, r4.w} + q2;
                    float qy = q2.x + q2.y; qy = row16_sum(qy);
                    ykeep = (kq == st) ? qy : ykeep;
                    if (st + 3 < SC_TC) SC_LOAD(sl, st + 3);
                }
#undef SC_LOAD
                asm volatile("" ::: "memory");
                if (lane == 0) __hip_atomic_fetch_add(done + b, 1u, __ATOMIC_RELAXED, __HIP_MEMORY_SCOPE_WORKGROUP);
                asm volatile("" ::: "memory");
                Y[(size_t)(m0 + c * SC_TC + kq) * 1024 + h * 64 + row] = ykeep;
            }
            *(f32x4*)(Sout + row * 64 + kq * 4) = (f32x4){Sa.x, Sa.y, Sb.x, Sb.y};
        }
        gc += nch;
    }
}

DI void attn_wave_task(const Params& p, LAS float* tbl, LAS unsigned char* kv, const int task, const int lane) {
    unsigned char* ws = p.ws;
    const bf16_t* QK = (const bf16_t*)(ws + WS_QK); const bf16_t* VT = (const bf16_t*)(ws + WS_VT); bf16_t* MIX = (bf16_t*)(ws + WS_MIXIN);
    const int c = 31 - (task >> 7), rem = task & 127, b = rem >> 5, h = (rem >> 1) & 15, half = rem & 1;
    for (int i = lane; i < 257; i += 64) tbl[i] = p.in[I_RB][h * 257 + i] * LOG2E;
    const int n = lane & 31, hf = lane >> 5;
    const int mq = b * SEQ + c * 64 + half * 32 + n;
    bf16x8 Qf[4];
#pragma unroll
    for (int s = 0; s < 4; ++s) Qf[s] = *(const bf16x8*)(QK + (size_t)mq * 2048 + h * 64 + 16 * s + 8 * hf);
    f32x16 O[2]; for (int i = 0; i < 16; ++i) { O[0][i] = 0.f; O[1][i] = 0.f; }
    float mrun = -1e30f, lrun = 0.f;
    const int kc0 = c - 8 < 0 ? 0 : c - 8;
    LAS unsigned char* kt = kv; LAS unsigned char* vt = kv + 64 * KV_STRIDE;
    const int srow = lane >> 3, spc = lane & 7;
    u32x4 kreg[8], vreg[8];
#define KV_FETCH(kcx) do { const bf16_t* kg = QK + (size_t)(b * SEQ + (kcx) * 64 + srow) * 2048 + 1024 + h * 64 + spc * 8; const bf16_t* vg = VT + (size_t)(h * 64 + srow) * MPAD + (size_t)b * SEQ + (kcx) * 64 + spc * 8; \
        _Pragma("unroll") for (int i = 0; i < 8; ++i) { kreg[i] = *(const u32x4*)(kg + (size_t)i * 8 * 2048); vreg[i] = *(const u32x4*)(vg + (size_t)i * 8 * MPAD); } } while (0)
#define KV_STORE() do { _Pragma("unroll") for (int i = 0; i < 8; ++i) { *(LAS u32x4*)(kt + (i * 8 + srow) * KV_STRIDE + spc * 16) = kreg[i]; *(LAS u32x4*)(vt + (i * 8 + srow) * KV_STRIDE + spc * 16) = vreg[i]; } } while (0)
    KV_FETCH(kc0);
    KV_STORE();
    for (int kc = kc0; kc <= c; ++kc) {
        { const int kn = kc < c ? kc + 1 : kc; KV_FETCH(kn); }
        f32x16 Sx[2];
#pragma unroll
        for (int kb = 0; kb < 2; ++kb) { for (int i = 0; i < 16; ++i) Sx[kb][i] = 0.f;
#pragma unroll
            for (int s = 0; s < 4; ++s) Sx[kb] = MFMA32(*(const LAS bf16x8*)(kt + (kb * 32 + n) * KV_STRIDE + 16 * hf + 32 * s), Qf[s], Sx[kb]); }
        const int dist0 = (c - kc) * 64 + half * 32 + n;
        float mx = -1e30f; float ebias = 0.f; const bool far = c - kc >= 3;
        if (far) { ebias = tbl[256];
#pragma unroll
            for (int kb = 0; kb < 2; ++kb)
#pragma unroll
                for (int i = 0; i < 16; ++i) mx = fmaxf(mx, Sx[kb][i]);
            mx = mx * LOG2E + ebias; }
        else {
#pragma unroll
            for (int kb = 0; kb < 2; ++kb)
#pragma unroll
                for (int i = 0; i < 16; ++i) { int rel = dist0 - kb * 32 - crow(i, hf); rel = rel < -128 ? -128 : (rel > 128 ? 128 : rel);
                    Sx[kb][i] = Sx[kb][i] * LOG2E + tbl[rel + 128]; mx = fmaxf(mx, Sx[kb][i]); } }
        mx = fmaxf(mx, __shfl_xor(mx, 32));
        const float mnew = fmaxf(mrun, mx); const float alpha = __builtin_amdgcn_exp2f(mrun - mnew); mrun = mnew;
        float ls = 0.f; const float esc = far ? LOG2E : 1.f, eoff = (far ? ebias : 0.f) - mnew;
#pragma unroll
        for (int kb = 0; kb < 2; ++kb)
#pragma unroll
            for (int i = 0; i < 16; ++i) { Sx[kb][i] = __builtin_amdgcn_exp2f(Sx[kb][i] * esc + eoff); ls += Sx[kb][i]; }
        lrun = lrun * alpha + ls;
#pragma unroll
        for (int i = 0; i < 16; ++i) { O[0][i] *= alpha; O[1][i] *= alpha; }
#pragma unroll
        for (int kb = 0; kb < 2; ++kb)
#pragma unroll
            for (int s2 = 0; s2 < 2; ++s2) {
                u32x4 pp; pp.x = pk2(Sx[kb][8 * s2], Sx[kb][8 * s2 + 1]); pp.y = pk2(Sx[kb][8 * s2 + 2], Sx[kb][8 * s2 + 3]); pp.z = pk2(Sx[kb][8 * s2 + 4], Sx[kb][8 * s2 + 5]); pp.w = pk2(Sx[kb][8 * s2 + 6], Sx[kb][8 * s2 + 7]);
                const bf16x8 Pf = __builtin_bit_cast(bf16x8, pp);
#pragma unroll
                for (int db = 0; db < 2; ++db) { const LAS unsigned char* vp = vt + (db * 32 + n) * KV_STRIDE + (kb * 32 + 16 * s2 + 4 * hf) * 2;
                    const s16x4 lo = *(const LAS s16x4*)vp, hi = *(const LAS s16x4*)(vp + 16);
                    const bf16x8 Vf = __builtin_shufflevector(lo, hi, 0, 1, 2, 3, 4, 5, 6, 7);
                    O[db] = MFMA32(Vf, Pf, O[db]); } }
        asm volatile("" ::: "memory");
        KV_STORE();
        asm volatile("" ::: "memory");
    }
#undef KV_FETCH
#undef KV_STORE
    const float l = lrun + __shfl_xor(lrun, 32); const float inv = 1.f / l;
#pragma unroll
    for (int db = 0; db < 2; ++db)
#pragma unroll
        for (int g4 = 0; g4 < 4; ++g4) { const int d0 = db * 32 + 8 * g4 + 4 * hf; u32x2 o; o.x = pk2(O[db][4 * g4] * inv, O[db][4 * g4 + 1] * inv); o.y = pk2(O[db][4 * g4 + 2] * inv, O[db][4 * g4 + 3] * inv);
            *(u32x2*)(MIX + (size_t)mq * 2048 + h * 64 + d0) = o; }
}

DI void attn_sample_wave(const Params& p, LAS float* tbl, const int bh, const int lane) {
    unsigned char* ws = p.ws;
    const bf16_t* QK = (const bf16_t*)(ws + WS_QK); const bf16_t* VT = (const bf16_t*)(ws + WS_VT); bf16_t* MIX = (bf16_t*)(ws + WS_MIXIN);
    const bf16_t* KC = (const bf16_t*)(ws + WS_KC); const bf16_t* VTC = (const bf16_t*)(ws + WS_VTC);
    const int b = bh >> 4, h = bh & 15;
    for (int i = lane; i < 257; i += 64) tbl[i] = p.in[I_RB][h * 257 + i] * LOG2E;
    const int n = lane & 31, hf = lane >> 5, qi = n & 15;
    const int mq = MPR + b * 16 + qi;
    bf16x8 Qf[4];
#pragma unroll
    for (int s = 0; s < 4; ++s) Qf[s] = *(const bf16x8*)(QK + (size_t)mq * 2048 + h * 64 + 16 * s + 8 * hf);
    f32x16 O[2]; for (int i = 0; i < 16; ++i) { O[0][i] = 0.f; O[1][i] = 0.f; }
    float mrun = -1e30f, lrun = 0.f;
#pragma unroll 1
    for (int kc = 0; kc < 9; ++kc) {
        f32x16 Sx[2];
#pragma unroll
        for (int kb = 0; kb < 2; ++kb) { for (int i = 0; i < 16; ++i) Sx[kb][i] = 0.f;
            const bf16_t* kp = kc < 8 ? KC + ((size_t)(b * 512 + kc * 64 + kb * 32 + n) * 1024 + h * 64 + 8 * hf) : QK + (size_t)(MPR + b * 16 + qi) * 2048 + 1024 + h * 64 + 8 * hf;
#pragma unroll
            for (int s = 0; s < 4; ++s) Sx[kb] = MFMA32(*(const bf16x8*)(kp + 16 * s), Qf[s], Sx[kb]); }
        s16x4 Vlo[2][2][2], Vhi[2][2][2];
#pragma unroll
        for (int kb = 0; kb < 2; ++kb)
#pragma unroll
            for (int s2 = 0; s2 < 2; ++s2)
#pragma unroll
                for (int db = 0; db < 2; ++db) { const bf16_t* vp = kc < 8 ? VTC + ((size_t)(b * 1024 + h * 64 + db * 32 + n) * 512 + kc * 64 + kb * 32 + 16 * s2 + 4 * hf)
                                                                       : VT + (size_t)(h * 64 + db * 32 + n) * MPAD + MPR + b * 16 + kb * 32 + 16 * s2 + 4 * hf;
                    Vlo[kb][s2][db] = *(const s16x4*)vp; Vhi[kb][s2][db] = *(const s16x4*)(vp + 8); }
        float mx = -1e30f;
#pragma unroll
        for (int kb = 0; kb < 2; ++kb)
#pragma unroll
            for (int i = 0; i < 16; ++i) { const int j = kc * 64 + kb * 32 + crow(i, hf); int rel = 512 + qi - j; rel = rel < -128 ? -128 : (rel > 128 ? 128 : rel);
                float sv = Sx[kb][i] * LOG2E + tbl[rel + 128]; sv = j < 528 ? sv : -1e30f; Sx[kb][i] = sv; mx = fmaxf(mx, sv); }
        mx = fmaxf(mx, __shfl_xor(mx, 32));
        const float mnew = fmaxf(mrun, mx); const float alpha = __builtin_amdgcn_exp2f(mrun - mnew); mrun = mnew;
        float ls = 0.f;
#pragma unroll
        for (int kb = 0; kb < 2; ++kb)
#pragma unroll
            for (int i = 0; i < 16; ++i) { Sx[kb][i] = __builtin_amdgcn_exp2f(Sx[kb][i] - mnew); ls += Sx[kb][i]; }
        lrun = lrun * alpha + ls;
#pragma unroll
        for (int i = 0; i < 16; ++i) { O[0][i] *= alpha; O[1][i] *= alpha; }
#pragma unroll
        for (int kb = 0; kb < 2; ++kb)
#pragma unroll
            for (int s2 = 0; s2 < 2; ++s2) {
                u32x4 pp; pp.x = pk2(Sx[kb][8 * s2], Sx[kb][8 * s2 + 1]); pp.y = pk2(Sx[kb][8 * s2 + 2], Sx[kb][8 * s2 + 3]); pp.z = pk2(Sx[kb][8 * s2 + 4], Sx[kb][8 * s2 + 5]); pp.w = pk2(Sx[kb][8 * s2 + 6], Sx[kb][8 * s2 + 7]);
                const bf16x8 Pf = __builtin_bit_cast(bf16x8, pp);
#pragma unroll
                for (int db = 0; db < 2; ++db) { const bf16x8 Vf = __builtin_shufflevector(Vlo[kb][s2][db], Vhi[kb][s2][db], 0, 1, 2, 3, 4, 5, 6, 7);
                    O[db] = MFMA32(Vf, Pf, O[db]); } }
    }
    const float l = lrun + __shfl_xor(lrun, 32); const float inv = 1.f / l;
    if (n < 16) {
#pragma unroll
        for (int db = 0; db < 2; ++db)
#pragma unroll
            for (int g4 = 0; g4 < 4; ++g4) { const int d0 = db * 32 + 8 * g4 + 4 * hf; u32x2 o; o.x = pk2(O[db][4 * g4] * inv, O[db][4 * g4 + 1] * inv); o.y = pk2(O[db][4 * g4 + 2] * inv, O[db][4 * g4 + 3] * inv);
                *(u32x2*)(MIX + (size_t)mq * 2048 + h * 64 + d0) = o; } }
}

DI void attn_sample_task(const Params& p, LAS unsigned char* lds, int bt, const int tid_o) {
    const int tid = tid_o, wave = tid >> 6, lane = tid & 63;
    unsigned char* ws = p.ws;
    const bf16_t* QK = (const bf16_t*)(ws + WS_QK); const bf16_t* VT = (const bf16_t*)(ws + WS_VT); bf16_t* MIX = (bf16_t*)(ws + WS_MIXIN);
    const int b = bt >> 4, h = bt & 15;
    LAS float* qs = (LAS float*)lds;
    LAS float* sc = qs + 1024;
    LAS float* tbl = sc + 16 * 528;
    LAS float* rinv = tbl + 260;
    __syncthreads();
    for (int i = tid; i < 1024; i += 512) qs[i] = bf1(QK[(size_t)(MPR + b * 16 + (i >> 6)) * 2048 + h * 64 + (i & 63)]);
    for (int i = tid; i < 257; i += 512) tbl[i] = p.in[I_RB][h * 257 + i];
    __syncthreads();
    for (int j = tid; j < 528; j += 512) {
        float kv[64];
        if (j < 512) { const float* kp = p.in[I_CK] + (((size_t)b * 512 + j) * 16 + h) * 64;
#pragma unroll
            for (int d = 0; d < 16; ++d) { const f32x4 v = *(const f32x4*)(kp + 4 * d); kv[4 * d] = v.x; kv[4 * d + 1] = v.y; kv[4 * d + 2] = v.z; kv[4 * d + 3] = v.w; } }
        else { const bf16_t* kp = QK + (size_t)(MPR + b * 16 + (j - 512)) * 2048 + 1024 + h * 64;
#pragma unroll
            for (int d = 0; d < 8; ++d) unpack8(*(const u32x4*)(kp + 8 * d), kv + 8 * d); }
        for (int i = 0; i < 16; ++i) { float s = 0.f;
#pragma unroll
            for (int d = 0; d < 64; ++d) s += qs[i * 64 + d] * kv[d];
            int rel = 512 + i - j; rel = rel < -128 ? -128 : (rel > 128 ? 128 : rel);
            sc[i * 528 + j] = s + tbl[rel + 128]; }
    }
    __syncthreads();
    for (int i = wave * 2; i < wave * 2 + 2; ++i) { float mx = -1e30f;
        for (int j = lane; j < 528; j += 64) mx = fmaxf(mx, sc[i * 528 + j]);
#pragma unroll
        for (int o = 1; o < 64; o <<= 1) mx = fmaxf(mx, __shfl_xor(mx, o));
        float sum = 0.f;
        for (int j = lane; j < 528; j += 64) { const float e = __expf(sc[i * 528 + j] - mx); sc[i * 528 + j] = e; sum += e; }
        sum = wave_sum(sum);
        if (lane == 0) rinv[i] = 1.f / sum; }
    __syncthreads();
    {
        LAS float* red = rinv + 16;
        const int d = tid & 63, kg = tid >> 6; float acc[16];
#pragma unroll
        for (int i = 0; i < 16; ++i) acc[i] = 0.f;
        const float* vp = p.in[I_CV] + ((size_t)b * 512 * 16 + h) * 64 + d;
        const bf16_t* vt = VT + (size_t)(h * 64 + d) * MPAD + MPR + b * 16;
#pragma unroll 1
        for (int j0 = kg * 66; j0 < kg * 66 + 66; j0 += 11) { float v[11];
#pragma unroll
            for (int u = 0; u < 11; ++u) { const int j = j0 + u; const int jc = j < 512 ? j : 511; const float vc = vp[(size_t)jc * 1024]; const float vn = bf1(vt[j < 512 ? 0 : j - 512]); v[u] = j < 512 ? vc : vn; }
#pragma unroll
            for (int u = 0; u < 11; ++u)
#pragma unroll
                for (int i = 0; i < 16; ++i) acc[i] += sc[i * 528 + j0 + u] * v[u]; }
#pragma unroll
        for (int i = 0; i < 16; ++i) red[(kg * 16 + i) * 64 + d] = acc[i];
        __syncthreads();
        for (int o = tid; o < 1024; o += 512) { const int i = o >> 6, dd = o & 63; float sum = 0.f;
#pragma unroll
            for (int g = 0; g < 8; ++g) sum += red[(g * 16 + i) * 64 + dd];
            MIX[(size_t)(MPR + b * 16 + i) * 2048 + h * 64 + dd] = (bf16_t)(pk2(sum * rinv[i], 0.f) & 0xffffu); }
    }
}

DI void phase_mix(const Params& p, LAS unsigned char* lds, const int tid_o) {
    const int blk = blockIdx.x, G = gridDim.x;
    const int wave = __builtin_amdgcn_readfirstlane(tid_o >> 6), lane = tid_o & 63;
    __syncthreads();
    if (tid_o < 2 * SC_NB + 4) ((LAS unsigned*)(lds + L_FLAGS))[tid_o] = 0u;
    __syncthreads();
    if (wave <= 3) __builtin_amdgcn_s_setprio(3);
    if (wave <= 5) { scan_run(p, lds, wave, lane, blk, G);
        LAS unsigned* sdone = (LAS unsigned*)(lds + L_FLAGS) + 8;
        asm volatile("" ::: "memory");
        if (lane == 0) __hip_atomic_fetch_add(sdone, 1u, __ATOMIC_RELAXED, __HIP_MEMORY_SCOPE_WORKGROUP);
        if (wave <= 3) { while (__hip_atomic_load(sdone, __ATOMIC_RELAXED, __HIP_MEMORY_SCOPE_WORKGROUP) < 6u) __builtin_amdgcn_s_sleep(1); asm volatile("" ::: "memory"); } }
#if REPEAT_SUB == 1
    __syncthreads();
    if (tid_o < 2 * SC_NB) ((LAS unsigned*)(lds + L_FLAGS))[tid_o] = 0u;
    __syncthreads();
    if (wave <= 5) scan_run(p, lds, wave, lane, blk, G);
#endif
    __builtin_amdgcn_s_setprio(0);
    if (wave <= 3 || wave >= 6) {
        LAS float* tbl = (LAS float*)(lds + L_TBL + wave * 1040);
        LAS unsigned char* kv = wave >= 6 ? lds + L_KV + (wave - 6) * KV_BYTES : lds + wave * KV_BYTES;
        const unsigned myq = (unsigned)__builtin_amdgcn_s_getreg((3 << 11) | 20) & 7u;
        for (unsigned qo = 0; qo < 8u; ++qo) { const unsigned q = (myq + qo) & 7u; unsigned* ctr = (unsigned*)(p.ws + WS_CTR) + 128 + 16 * q;
            for (;;) { unsigned t = 0; if (lane == 0) t = atomicAdd(ctr, 1u); t = __builtin_amdgcn_readfirstlane(t); if (t >= 528u) break;
                if (t < 16u) attn_sample_wave(p, tbl, (int)(q + 8u * t), lane);
                else { const unsigned tp = t - 16u, rem = tp & 15u, bhp = q + 8u * (rem >> 1); const int task = (int)((tp >> 4) * 128u + (bhp >> 4) * 32u + (bhp & 15u) * 2u + (rem & 1u));
                    attn_wave_task(p, tbl, kv, task, lane); } } }
    }
}

DI void phase_post(const Params& p, const int tid_o) {
    const int tid = tid_o, wave = tid >> 6, lane = tid & 63, blk = blockIdx.x, G = gridDim.x;
    unsigned char* ws = p.ws;
    const float* Y = (const float*)(ws + WS_Y); const bf16_t* FV = (const bf16_t*)(ws + WS_FV); const bf16_t* GG = (const bf16_t*)(ws + WS_GG); const float* BON = (const float*)(ws + WS_BONUS);
    bf16_t* MIX = (bf16_t*)(ws + WS_MIXIN);
    const int gw = blk * 8 + wave, NGW = G * 8;
    for (int i = blk * 512 + tid; i < MS * DM / 4; i += G * 512) *(f32x4*)(p.out + (size_t)MPR * DM + (size_t)i * 4) = *(const f32x4*)(p.in[I_XS] + (size_t)i * 4);
    { float* out = p.out; const bf16_t* VT = (const bf16_t*)(ws + WS_VT);
    for (int task = gw; task < 16 * 34; task += NGW) { const int cb = task & 15, mc = task >> 4; const int c = cb * 64 + lane;
        const int mbase = mc < 32 ? ((mc >> 3) * SEQ + (SEQ - 512) + (mc & 7) * 64) : MPR + (mc - 32) * 64;
        float* ob = mc < 32 ? out + O_VP + ((size_t)(mc >> 3) * 512 + (mc & 7) * 64) * 1024 + c : out + O_VS + (size_t)((mc - 32) * 64) * 1024 + c;
        u32x4 raw[8];
#pragma unroll
        for (int j = 0; j < 8; ++j) raw[j] = *(const u32x4*)(VT + (size_t)c * MPAD + mbase + 8 * j);
#pragma unroll
        for (int j = 0; j < 8; ++j) { float f[8]; unpack8(raw[j], f);
#pragma unroll
            for (int e = 0; e < 8; ++e) ob[(size_t)(8 * j + e) * 1024] = f[e]; __builtin_amdgcn_sched_barrier(0); } }
    }
    for (int m = gw; m < MT; m += NGW) {
#pragma unroll
        for (int it = 0; it < 2; ++it) { const int c = it * 512 + lane * 8, h = c >> 6;
            const f32x4 y0 = __builtin_nontemporal_load((const f32x4*)(Y + (size_t)m * 1024 + c)), y1 = __builtin_nontemporal_load((const f32x4*)(Y + (size_t)m * 1024 + c + 4));
            float y[8] = {y0.x, y0.y, y0.z, y0.w, y1.x, y1.y, y1.z, y1.w};
            float s = 0.f;
#pragma unroll
            for (int j = 0; j < 8; ++j) s += y[j];
            s += __shfl_xor(s, 1); s += __shfl_xor(s, 2); s += __shfl_xor(s, 4);
            const float mu = s * (1.f / 64.f); float v2 = 0.f;
#pragma unroll
            for (int j = 0; j < 8; ++j) { y[j] -= mu; v2 += y[j] * y[j]; }
            v2 += __shfl_xor(v2, 1); v2 += __shfl_xor(v2, 2); v2 += __shfl_xor(v2, 4);
            const float rstd = rsqrtf(v2 * (1.f / 64.f) + 64e-5f);
            float vv[8], gg[8]; unpack8(__builtin_nontemporal_load((const u32x4*)(FV + (size_t)m * 1024 + c)), vv); unpack8(__builtin_nontemporal_load((const u32x4*)(GG + (size_t)m * 1024 + c)), gg);
            const float bon = BON[(size_t)m * 16 + h];
            const float* lw = p.in[I_LW] + c; const float* lb = p.in[I_LB] + c;
            float o[8];
#pragma unroll
            for (int j = 0; j < 8; ++j) { const float yn = y[j] * rstd * lw[j] + lb[j]; o[j] = (yn + bon * vv[j]) * gg[j]; }
            u32x4 q; q.x = pk2(o[0], o[1]); q.y = pk2(o[2], o[3]); q.z = pk2(o[4], o[5]); q.w = pk2(o[6], o[7]);
            *(u32x4*)(MIX + (size_t)m * 2048 + 1024 + c) = q; }
    }
}

DI void phase_act(const Params& p, const int tid_o) {
    const int tid = tid_o, blk = blockIdx.x, G = gridDim.x;
    unsigned char* ws = p.ws; float* out = p.out;
    bf16_t* GV = (bf16_t*)(ws + WS_GV);
    const float* cst = p.in[I_SC];
    for (int it = blk * 512 + tid; it < 130 * 704; it += G * 512) {
        const int f = (it % 704) * 8, strip = it / 704, m0 = strip * 64;
        float w0[8], w1[8], w2[8], bb[8];
#pragma unroll
        for (int j = 0; j < 8; ++j) { w0[j] = p.in[I_DWC][f + j]; w1[j] = p.in[I_DWC][DFF + f + j]; w2[j] = p.in[I_DWC][2 * DFF + f + j]; bb[j] = p.in[I_DWB][f + j]; }
        float p1[8], p2[8];
        for (int r0 = 0; r0 < 64; r0 += 4) {
            u32x4 craw[4], vraw[4];
#pragma unroll
            for (int rr = 0; rr < 4; ++rr) { craw[rr] = __builtin_nontemporal_load((const u32x4*)(GV + (size_t)(m0 + r0 + rr) * (2 * DFF) + f)); vraw[rr] = __builtin_nontemporal_load((const u32x4*)(GV + (size_t)(m0 + r0 + rr) * (2 * DFF) + DFF + f)); }
#pragma unroll
            for (int rr = 0; rr < 4; ++rr) { const int r = r0 + rr, m = m0 + r;
                int t, b; const bool samp = m >= MPR; if (samp) { t = (m - MPR) & 15; b = (m - MPR) >> 4; } else { t = m & (SEQ - 1); b = m >> 11; }
                if (r == 0 || t == 0) {
#pragma unroll
                    for (int off = 1; off <= 2; ++off) { float* d = off == 1 ? p1 : p2;
                        if (t - off >= 0) unpack8(*(const u32x4*)(GV + (size_t)(m - off) * (2 * DFF) + f), d);
                        else if (samp) { const float* sp = cst + ((size_t)b * 2 + (2 + t - off)) * DFF + f;
#pragma unroll
                            for (int j = 0; j < 8; ++j) d[j] = sp[j]; }
                        else {
#pragma unroll
                            for (int j = 0; j < 8; ++j) d[j] = 0.f; } } }
                float cur[8], val[8]; unpack8(craw[rr], cur); unpack8(vraw[rr], val);
                float o[8];
#pragma unroll
                for (int j = 0; j < 8; ++j) { const float cv = bb[j] + w0[j] * p2[j] + w1[j] * p1[j] + w2[j] * cur[j]; o[j] = gelu_f(cv) * val[j]; }
                u32x4 q; q.x = pk2(o[0], o[1]); q.y = pk2(o[2], o[3]); q.z = pk2(o[4], o[5]); q.w = pk2(o[6], o[7]);
                *(u32x4*)(GV + (size_t)m * (2 * DFF) + DFF + f) = q;
                const int tl = samp ? 14 : SEQ - 2;
                if (t >= tl) { float* op = out + (samp ? O_CVS : O_CVP) + ((size_t)b * 2 + (t - tl)) * DFF + f;
                    *(f32x4*)op = (f32x4){cur[0], cur[1], cur[2], cur[3]}; *(f32x4*)(op + 4) = (f32x4){cur[4], cur[5], cur[6], cur[7]}; }
#pragma unroll
                for (int j = 0; j < 8; ++j) { p2[j] = p1[j]; p1[j] = cur[j]; }
            }
        }
    }
}

#define XB_TMO      128
#define XB_XCNT(j)  (256  + 64 * (j))
#define XB_XSUB(j)  (1280 + 64 * (j))
#define XB_XGEN(j)  (2304 + 64 * (j))
#define XB_TOP      3328
#define XB_TOPGEN   3392
#define XCD_BAR_WORDS 3456
#define XB_SPIN_CAP (1u << 20)
DI unsigned xb_ld(unsigned* p)              { return __hip_atomic_load(p, __ATOMIC_RELAXED, __HIP_MEMORY_SCOPE_AGENT); }
DI unsigned xb_add(unsigned* p, unsigned v) { return __hip_atomic_fetch_add(p, v, __ATOMIC_RELAXED, __HIP_MEMORY_SCOPE_AGENT); }
DI unsigned xb_xcc_id() { return (unsigned)__builtin_amdgcn_s_getreg((3 << 11) | 20) & 0xFu; }
#define XB_SPIN(cond, bar) do { unsigned _sp = 0; while (cond) { __builtin_amdgcn_s_sleep(1); \
    if ((++_sp & 255u) == 0u) { if (xb_ld(&(bar)[XB_TMO])) break; if (_sp > XB_SPIN_CAP) { atomicAdd(&(bar)[XB_TMO], 1u); break; } } } } while (0)
DI void xcd_barrier_complete(unsigned* bar, unsigned x, unsigned& nloc, unsigned& nx) {
    const unsigned G = gridDim.x;
    unsigned sum, cnt, mine, sp = 0u;
    for (;;) {
        sum = 0u; cnt = 0u; mine = 0u;
#pragma unroll
        for (unsigned j = 0; j < 16; ++j) { const unsigned c = xb_ld(&bar[XB_XCNT(j)]); sum += c; cnt += (c > 0u) ? 1u : 0u; mine = (j == x) ? c : mine; }
        if (sum == G) break;
        __builtin_amdgcn_s_sleep(1);
        if ((++sp & 255u) == 0u) { if (xb_ld(&bar[XB_TMO])) break; if (sp > XB_SPIN_CAP) { atomicAdd(&bar[XB_TMO], 1u); break; } }
    }
    nloc = mine > 0u ? mine : 1u; nx = cnt > 0u ? cnt : 1u;
}
DI void xcd_barrier(unsigned* bar, const unsigned x, volatile LAS unsigned* st, const int tid_o) {
    asm volatile("s_waitcnt vmcnt(0)" ::: "memory");
    __syncthreads();
    if (tid_o == 0) {
        __builtin_amdgcn_s_waitcnt(0);
        unsigned nloc = st[0], nx = st[1];
        if (nloc == 0u) { xcd_barrier_complete(bar, x, nloc, nx); st[0] = nloc; st[1] = nx; }
        const unsigned old = xb_add(&bar[XB_XSUB(x)], 1u);
        const unsigned gen = old / nloc;
        if (old + 1u == (gen + 1u) * nloc) {
            __builtin_amdgcn_fence(__ATOMIC_RELEASE, "agent");
            asm volatile("s_waitcnt vmcnt(0)" ::: "memory");
            const unsigned og = xb_add(&bar[XB_TOP], 1u);
            const unsigned tg = og / nx;
            if (og + 1u == (tg + 1u) * nx) xb_add(&bar[XB_TOPGEN], 1u);
            else XB_SPIN(xb_ld(&bar[XB_TOPGEN]) == tg, bar);
            __builtin_amdgcn_fence(__ATOMIC_ACQUIRE, "agent");
            xb_add(&bar[XB_XGEN(x)], 1u);
            asm volatile("s_waitcnt vmcnt(0)" ::: "memory");
        } else {
            XB_SPIN(xb_ld(&bar[XB_XGEN(x)]) == gen, bar);
            __builtin_amdgcn_fence(__ATOMIC_ACQUIRE, "agent");
            asm volatile("s_waitcnt vmcnt(0)" ::: "memory");
        }
    }
    __syncthreads();
}

constexpr int NPHASE = 10;
__global__ void __launch_bounds__(512, 2) mega(Params p) {
    extern __shared__ __attribute__((aligned(16))) unsigned char shm[];
    LAS unsigned char* lds = (LAS unsigned char*)shm;
    cg::grid_group grid = cg::this_grid();
    unsigned char* ws = p.ws;
    const int G = gridDim.x, c = blockIdx.x;
#if PROG == 1
    constexpr int PROGRAM[] = {0, 1, 2, 3, 2, 3, 4, 5, 6, 7, 8, 9, 10};
#elif PROG == 2
    constexpr int PROGRAM[] = {0, 1, 2, 3, 4, 5, 6, 7, 8, 9, 8, 9, 10};
#elif PROG == 3
    constexpr int PROGRAM[] = {0, 1, 2, 3, 4, 5, 6, 7, 8, 9, 10, 5, 6, 10};
#elif PROG == 4
    constexpr int PROGRAM[] = {0, 1, 2, 3, 4, 5, 6, 5, 6, 7, 8, 9, 10};
#elif PROG == 5
    constexpr int PROGRAM[] = {0, 1, 2, 3, 4, 2, 3, 4, 5, 6, 7, 8, 9, 10};
#elif PROG == 7
    constexpr int PROGRAM[] = {0, 1, 2, 3, 4, 5, 6, 7, 8, 9, 11, 10};
#elif PROG == 8
    constexpr int PROGRAM[] = {0, 12, 12, 12, 12, 12, 12, 12, 12, 12, 12, 1, 2, 3, 4, 5, 6, 7, 8, 9, 10};
#elif PROG == 6
    constexpr int PROGRAM[] = {0, 0, 1, 1, 2, 3, 4, 5, 6, 7, 7, 8, 9, 10};
#else
    constexpr int PROGRAM[] = {0, 1, 2, 3, 4, 5, 6, 7, 8, 9, 10, 13};
#endif
    constexpr int NPROG = sizeof(PROGRAM) / sizeof(int);
    unsigned* xbar = (unsigned*)(ws + WS_BAR); const unsigned xcc = xb_xcc_id(); volatile LAS unsigned* xst = (volatile LAS unsigned*)(lds + 132864);
    if (threadIdx.x < 4) xst[threadIdx.x] = 0u;
    if (threadIdx.x == 0) (void)xb_add(&xbar[XB_XCNT(xcc)], 1u);
    __syncthreads();
    for (int pi = p.ph_lo; pi < p.ph_hi; ++pi) {
        int ph = 0;
#pragma unroll
        for (int q = 0; q < NPROG; ++q) if (q == pi) ph = PROGRAM[q];
        int tid_o = threadIdx.x; asm volatile("" : "+v"(tid_o));
        switch (ph) {
#ifndef ONLY
#define ONLY -1
#endif
#define PHON(x) (ONLY < 0 || ONLY == (x))
        case 0: if (PHON(0)) phase0(p, lds, tid_o); break;
        case 1: if (PHON(1)) phase_norm<0>(p, lds, tid_o); break;
        case 2: if (PHON(2)) { SchedIn S; S.H = (const char*)(ws + WS_H); S.W = (const char*)(ws + WS_WT_IN); S.G = G; S.c = c; S.base = 0; S.limit = G == 256 ? 768 : 825;
                  EpiIn E; E.QK = (bf16_t*)(ws + WS_QK); E.VT = (bf16_t*)(ws + WS_VT); E.ZR = (bf16_t*)(ws + WS_ZR);
                  pg8::gemm_phase(lds, pg8::GemmK{DM, DM, DM}, S, E, tid_o);
                  } break;
        case 3: if (PHON(3)) phase_prep(p, lds, tid_o); break;
        case 4: if (PHON(4)) phase_mix(p, lds, tid_o);
#if REPEAT_SUB == 4
            grid.sync(); if (blockIdx.x == 0 && tid_o < 64) ((unsigned*)(ws + WS_CTR))[tid_o] = 0u; grid.sync(); phase_mix(p, lds, tid_o);
#endif
            break;
        case 5: if (PHON(5)) phase_post(p, tid_o); break;
        case 6: if (PHON(6)) { SchedPlain S; S.A = (const char*)(ws + WS_MIXIN); S.B = (const char*)(ws + WS_WT_OUT); S.G = G; S.c = c; S.nM = 32; S.nN = 8; S.nfull = 256; S.ntK = DM / 64; S.total = 256 + 8 * 8; S.astep = (size_t)256 * DM * 2; S.bstep = (size_t)256 * DM * 2;
                  EpiRes<false> E; E.out = p.out; E.xp = p.in[I_XP]; E.xs = p.in[I_XS]; E.MOD = (const float*)(ws + WS_MOD); E.goff = 2 * DM; E.slab = (float*)(ws + WS_FV);
                  pg8::gemm_phase(lds, pg8::GemmK{DM, DM, DM}, S, E, tid_o); } break;
        case 7: if (PHON(7)) phase_norm<1>(p, lds, tid_o); break;
        case 8: if (PHON(8)) { SchedPlain S; S.A = (const char*)(ws + WS_H); S.B = (const char*)(ws + WS_WT_UP); S.G = G; S.c = c; S.nM = 33; S.nN = 44; S.nfull = 33 * 44; S.ntK = DM / 64; S.total = 33 * 44; S.astep = (size_t)256 * DM * 2; S.bstep = (size_t)256 * DM * 2;
                  EpiUp E; E.GV = (bf16_t*)(ws + WS_GV);
                  pg8::gemm_phase(lds, pg8::GemmK{DM, DM, DM}, S, E, tid_o); } break;
        case 9: if (PHON(9)) phase_act(p, tid_o); break;
#if PROG == 7
        case 11: { SchedPlain S; S.A = (const char*)(ws + WS_GV) + (size_t)DFF * 2; S.B = (const char*)(ws + WS_WT_DOWN); S.G = G; S.c = c; S.nM = 32; S.nN = 8; S.nfull = 256; S.ntK = DFF / 64; S.total = 256 + 8 * 22; S.astep = (size_t)256 * (2 * DFF) * 2; S.bstep = (size_t)256 * DFF * 2;
                  EpiNull E; E.sink = (float*)(ws + WS_CTR + 1024);
                  pg8::gemm_phase(lds, pg8::GemmK{DFF, 2 * DFF, DFF}, S, E, tid_o); } break;
#endif
        case 13: {
            const float* slab = (const float*)(ws + WS_FV); const float* MOD = (const float*)(ws + WS_MOD);
            for (int i = blockIdx.x * 512 + tid_o; i < MS * DM / 4; i += G * 512) { const int r = i >> 9, c4 = (i & 511) * 4; f32x4 sum = (f32x4){0.f, 0.f, 0.f, 0.f};
#pragma unroll
                for (int ks = 0; ks < 22; ++ks) sum += *(const f32x4*)(slab + ((size_t)ks * MS + r) * DM + c4);
                const f32x4 g = *(const f32x4*)(MOD + (size_t)(4 + (r >> 4)) * NMOD + 5 * DM + c4); f32x4* op = (f32x4*)(p.out + (size_t)(MPR + r) * DM + c4); *op = *op + g * sum; }
            } break;
        case 10: if (PHON(10)) { SchedPlain S; S.A = (const char*)(ws + WS_GV) + (size_t)DFF * 2; S.B = (const char*)(ws + WS_WT_DOWN); S.G = G; S.c = c; S.nM = 32; S.nN = 8; S.nfull = 256; S.ntK = DFF / 64; S.total = 256 + 8 * 22; S.astep = (size_t)256 * (2 * DFF) * 2; S.bstep = (size_t)256 * DFF * 2;
                  EpiRes<true> E; E.out = p.out; E.xp = nullptr; E.xs = nullptr; E.MOD = (const float*)(ws + WS_MOD); E.goff = 5 * DM; E.slab = (float*)(ws + WS_FV);
                  pg8::gemm_phase(lds, pg8::GemmK{DFF, 2 * DFF, DFF}, S, E, tid_o); } break;
        }
        if (pi + 1 < p.ph_hi) { if (p.ph_hi < 0) grid.sync(); xcd_barrier(xbar, xcc, xst, tid_o); }
    }
}

extern "C" void kernel_launch(void* const* d_in, const int* in_sizes, int n_in, void* d_out, int out_size, void* d_ws, size_t ws_size, hipStream_t stream) {
    constexpr size_t kDynLds = 133120;
    static int grid_blocks = 0;
    if (!grid_blocks) {
        int dev = 0, cus = 0, per_cu = 0;
        hipGetDevice(&dev);
        hipDeviceGetAttribute(&cus, hipDeviceAttributeMultiprocessorCount, dev);
        hipFuncSetAttribute((const void*)mega, hipFuncAttributeMaxDynamicSharedMemorySize, (int)kDynLds);
        hipOccupancyMaxActiveBlocksPerMultiprocessor(&per_cu, (const void*)mega, 512, kDynLds);
        if (per_cu < 1) per_cu = 1;
        grid_blocks = cus * per_cu;
        if (grid_blocks > 256) grid_blocks = 256;
    }
    Params p{};
    for (int i = 0; i < 33; ++i) p.in[i] = (const float*)d_in[i];
    p.out = (float*)d_out; p.ws = (unsigned char*)d_ws;
#if N_LAUNCH_PER_PHASE
    for (int ph = 0; ph < 11; ++ph) { p.ph_lo = ph; p.ph_hi = ph + 1; hipLaunchKernelGGL(mega, dim3(grid_blocks), dim3(512), kDynLds, stream, p); }
#else
    hipMemsetAsync((unsigned char*)d_ws + WS_BAR, 0, 16384, stream);
    p.ph_lo = 0; p.ph_hi = (PROG == 0) ? 12 : (PROG == 8 ? 21 : PROG == 7 ? 12 : ((PROG == 3 || PROG == 5 || PROG == 6) ? 14 : 13));
    void* args[] = {&p};
    hipError_t e = hipLaunchCooperativeKernel((const void*)mega, dim3(grid_blocks), dim3(512), args, kDynLds, stream);
    if (e != hipSuccess) fprintf(stderr, "cooperative launch failed: %s (grid %d)\n", hipGetErrorString(e), grid_blocks);
#endif
}
```

```cpp
#include <hip/hip_runtime.h>
#include <hip/hip_cooperative_groups.h>
#include <cstdio>
namespace cg = cooperative_groups;

#ifndef PROG
#define PROG 0
#endif
#ifndef REPEAT_SUB
#define REPEAT_SUB 0
#endif
#ifndef REPEAT_PHASE
#define REPEAT_PHASE -1
#endif
#ifndef N_LAUNCH_PER_PHASE
#define N_LAUNCH_PER_PHASE 0
#endif

#define DI __device__ __forceinline__
#define LAS __attribute__((address_space(3)))
typedef unsigned short bf16_t;
typedef short bf16x8 __attribute__((ext_vector_type(8)));
typedef short s16x4 __attribute__((ext_vector_type(4)));
typedef float f32x2 __attribute__((ext_vector_type(2)));
typedef float f32x4 __attribute__((ext_vector_type(4)));
typedef float f32x16 __attribute__((ext_vector_type(16)));
typedef unsigned u32x2 __attribute__((ext_vector_type(2)));
typedef unsigned u32x4 __attribute__((ext_vector_type(4)));
typedef __bf16 bf16x2_t __attribute__((ext_vector_type(2)));

constexpr int DM = 2048, SEQ = 2048, MPR = 8192, MS = 128, MT = 8320, MPAD = 8448;
constexpr int DIN = 6400, DSH = 3328, DFF = 5632, NMOD = 12288;
constexpr float LOG2E = 1.4426950408889634f;
enum { I_XP = 0, I_XS, I_CP, I_CS, I_CK, I_CV, I_SR, I_SS, I_SC, I_NAG, I_NFG, I_WADA, I_BADA, I_WIN, I_QG, I_KG, I_RB, I_MU, I_W0, I_W2, I_A0, I_A2, I_G2,
       I_KK, I_KA, I_RK, I_LW, I_LB, I_WOUT, I_WUP, I_DWC, I_DWB, I_WDN };
constexpr size_t O_Y = 0, O_KP = 17039360, O_VP = 19136512, O_SP = 21233664, O_SHP = 21495808, O_CVP = 21509120, O_KS = 21554176, O_VS = 21685248,
                 O_SS = 21816320, O_SHS = 22340608, O_CVS = 22367232;
constexpr size_t WS_WT_OUT = 0, WS_WT_UP = 8388608, WS_WT_DOWN = 54525952, WS_LT = 77594624, WS_MODP = 78118912, WS_MOD = 82837504, WS_BONUS = 83427328,
                 WS_CTR = 83959808, WS_BAR = 83963904, WS_R = 83963904 + 16384;
constexpr size_t WS_WT_IN = WS_R, WS_H = WS_R + 26214400, WS_MIXIN = WS_R, WS_GG = WS_R + 305004544  , WS_QK = WS_R + 60817408, WS_VT = WS_R + 95420416,
                 WS_ZR = WS_R + 112721920, WS_Y = WS_ZR, WS_FW = WS_R + 168951808, WS_FB = WS_R + 203030528, WS_FV = WS_R + 271187968, WS_GV = WS_QK, WS_KC = WS_R + 288227328, WS_VTC = WS_R + 288227328 + 8388608;

struct Params { const float* in[33]; float* out; unsigned char* ws; int ph_lo, ph_hi; };

DI unsigned pk2(float a, float b) { f32x2 v = {a, b}; bf16x2_t r = __builtin_convertvector(v, bf16x2_t); return __builtin_bit_cast(unsigned, r); }
DI float bflo(unsigned u) { return __uint_as_float(u << 16); }
DI float bfhi(unsigned u) { return __uint_as_float(u & 0xffff0000u); }
DI float bf1(bf16_t u) { return __uint_as_float(((unsigned)u) << 16); }
DI void unpack8(u32x4 v, float* f) { f[0] = bflo(v.x); f[1] = bfhi(v.x); f[2] = bflo(v.y); f[3] = bfhi(v.y); f[4] = bflo(v.z); f[5] = bfhi(v.z); f[6] = bflo(v.w); f[7] = bfhi(v.w); }
DI void unpack4(u32x2 v, float* f) { f[0] = bflo(v.x); f[1] = bfhi(v.x); f[2] = bflo(v.y); f[3] = bfhi(v.y); }
DI float wave_sum(float v) {
#pragma unroll
    for (int o = 1; o < 64; o <<= 1) v += __shfl_xor(v, o);
    return v;
}
DI float dpp_ror_add(float s, int) { return s; }
#define DPP_ADD(s, ctrl) ((s) + __builtin_bit_cast(float, __builtin_amdgcn_update_dpp(0, __builtin_bit_cast(int, (s)), (ctrl), 0xf, 0xf, false)))
DI float row16_sum(float s) { s = DPP_ADD(s, 0x128); s = DPP_ADD(s, 0x124); s = DPP_ADD(s, 0x122); s = DPP_ADD(s, 0x121); return s; }
DI int crow(int reg, int h) { return (reg & 3) + 8 * (reg >> 2) + 4 * h; }
DI float sigmoidf_(float x) { return 1.f / (1.f + __expf(-x)); }
#define MFMA32(a, b, c) __builtin_amdgcn_mfma_f32_32x32x16_bf16((a), (b), (c), 0, 0, 0)

DI float gelu_f(float v) {
    const float av = fabsf(v), d = av * 0.2316418882f + 1.0f;
    const float t = __builtin_amdgcn_rcpf(d);
    float q = t * 0.5307027145f + (-0.7265760135f); q = q * t + 0.7107068705f; q = q * t + (-0.142248368f); q = q * t + 0.127414796f; q = q * t;
    const float e = __builtin_amdgcn_exp2f((v * v) * (-0.72134752044f));
    const float m = v * (q * e), r = v - m;
    return v < 0.f ? m : r;
}

namespace pg8 {
constexpr int BM = 256, BK = 64, HALF = 128, HTB = HALF * BK * 2, STAGE_BYTES = 8 * HTB;
DI int lds_byte(int r, int c) { const int st = (r >> 4) * 2 + (c >> 5), rr = r & 15, cc = c & 31, ob = rr * 64 + cc * 2; return st * 1024 + (ob ^ (((ob >> 9) & 1) << 5)); }
DI void stage_rc(int b, int& R, int& C) { const int st = b / 1024, sb = b % 1024, swz = sb ^ (((sb >> 9) & 1) << 5); R = (st >> 1) * 16 + swz / 64; C = (st & 1) * 32 + (swz % 64) / 2; }
DI int perm32(int rho) { const int n = rho >> 4, i = rho & 15; return 8 * (i >> 2) + 4 * n + (i & 3); }
struct Unit { const char* a; const char* b; int kind, pm, pn, nt, ks; };
struct GemmK { int K, lda, ldb; };

template <class Epi, class Sched>
DI void gemm_phase(LAS unsigned char* lds, const GemmK g, const Sched& S, const Epi& E, const int tid_o) {
    const int tid = tid_o, wid = __builtin_amdgcn_readfirstlane(tid >> 6), lane = tid & 63, wr = wid >> 2, wc = wid & 3, fr = lane & 15, fq = lane >> 4;
    unsigned voffA[2], voffB[2];
#pragma unroll
    for (int i = 0; i < 2; ++i) { int R, C; stage_rc(tid * 16 + i * 8192, R, C); const int Rb = Epi::PERM ? ((R & ~31) + perm32(R & 31)) : R;
        voffA[i] = (unsigned)(R * g.lda + C) * 2u; voffB[i] = (unsigned)(Rb * g.ldb + C) * 2u; }
    const size_t kstep = (size_t)(BK * 2);
    const size_t hstepA = (size_t)HALF * g.lda * 2, hstepB = (size_t)HALF * g.ldb * 2;
    const unsigned ldsw = (unsigned)wid * 1024u;
    const int aoff = lds_byte(wr * 64 + fr, fq * 8), boff = lds_byte(wc * 32 + fr, fq * 8);
#define PG8_SA(b, h) (((b) * 2 + (h)) * HTB)
#define PG8_SB(b, h) ((4 + (b) * 2 + (h)) * HTB)
#define PG8_STAGE(bufoff, gbase, voff) do { _Pragma("unroll") for (int _i = 0; _i < 2; ++_i) \
        __builtin_amdgcn_global_load_lds((const unsigned*)((const char*)(gbase) + (voff)[_i]), (LAS unsigned*)(lds + (bufoff) + ldsw + _i * 8192), 16, 0, 0); } while (0)
#define PG8_LDA(dst, b, h) do { _Pragma("unroll") for (int m = 0; m < 4; ++m) _Pragma("unroll") for (int k = 0; k < 2; ++k) dst[m][k] = *(const LAS bf16x8*)(lds + PG8_SA(b, h) + aoff + m * 2048 + k * 1024); } while (0)
#define PG8_LDB(dst, b, h) do { _Pragma("unroll") for (int n = 0; n < 2; ++n) _Pragma("unroll") for (int k = 0; k < 2; ++k) dst[n][k] = *(const LAS bf16x8*)(lds + PG8_SB(b, h) + boff + n * 2048 + k * 1024); } while (0)
#define PG8_MMA(ai, bj, At, Bt) do { __builtin_amdgcn_s_setprio(1); _Pragma("unroll") for (int m = 0; m < 4; ++m) _Pragma("unroll") for (int n = 0; n < 2; ++n) _Pragma("unroll") for (int k = 0; k < 2; ++k) \
        acc[ai][bj][m][n] = __builtin_amdgcn_mfma_f32_16x16x32_bf16(Bt[n][k], At[m][k], acc[ai][bj][m][n], 0, 0, 0); __builtin_amdgcn_s_setprio(0); } while (0)
#define PG8_WAIT_V(n) asm volatile("s_waitcnt vmcnt(" #n ")" ::: "memory")
#define PG8_WAIT_L(n) asm volatile("s_waitcnt lgkmcnt(" #n ")" ::: "memory")
#define PG8_BAR __builtin_amdgcn_s_barrier()
#define PG8_SCHED __builtin_amdgcn_sched_barrier(0)
    Unit cur, nxt; int ui = 0;
    if (!S.next(0, cur)) return;
    f32x4 acc[2][2][4][2];
#pragma unroll
    for (int a = 0; a < 2; ++a)
#pragma unroll
        for (int b = 0; b < 2; ++b)
#pragma unroll
            for (int m = 0; m < 4; ++m)
#pragma unroll
                for (int n = 0; n < 2; ++n) acc[a][b][m][n] = (f32x4){0.f, 0.f, 0.f, 0.f};
    bf16x8 At[4][2], B0[2][2], B1[2][2];
    const char* cA = cur.a; const char* cB = cur.b;
    PG8_STAGE(PG8_SB(0, 0), cB, voffB); PG8_STAGE(PG8_SA(0, 0), cA, voffA); PG8_STAGE(PG8_SB(0, 1), cB + hstepB, voffB); PG8_STAGE(PG8_SA(0, 1), cA + hstepA, voffA);
    if (wr == 1) PG8_BAR;
    PG8_WAIT_V(4); PG8_BAR;
    PG8_STAGE(PG8_SB(1, 0), cB + kstep, voffB); PG8_STAGE(PG8_SA(1, 0), cA + kstep, voffA); PG8_STAGE(PG8_SB(1, 1), cB + hstepB + kstep, voffB);
    PG8_WAIT_V(6); PG8_BAR;
    for (;;) {
        const bool has_next = S.next(ui + 1, nxt);
        const char* nA = has_next ? nxt.a : cA; const char* nB = has_next ? nxt.b : cB;
        const int nt = cur.nt;
        for (int t = 0; t < nt; t += 2) {
            const bool last = (t == nt - 2);
            const char* a1 = cA + (size_t)(t + 1) * kstep;
            const char* a2 = last ? nA : cA + (size_t)(t + 2) * kstep; const char* b2 = last ? nB : cB + (size_t)(t + 2) * kstep;
            const char* a3 = a2 + kstep; const char* b3 = b2 + kstep;
            PG8_LDB(B0, 0, 0); PG8_SCHED; PG8_LDA(At, 0, 0); PG8_STAGE(PG8_SA(1, 1), a1 + hstepA, voffA);
            PG8_WAIT_L(8); PG8_BAR; PG8_WAIT_L(0); PG8_MMA(0, 0, At, B0); PG8_BAR; PG8_SCHED;
            PG8_LDB(B1, 0, 1); PG8_STAGE(PG8_SB(0, 0), b2, voffB);
            PG8_BAR; PG8_WAIT_L(0); PG8_MMA(0, 1, At, B1); PG8_BAR;
            PG8_LDA(At, 0, 1); PG8_STAGE(PG8_SA(0, 0), a2, voffA);
            PG8_BAR; PG8_WAIT_L(0); PG8_MMA(1, 0, At, B0); PG8_BAR; PG8_SCHED;
            PG8_STAGE(PG8_SB(0, 1), b2 + hstepB, voffB);
            PG8_WAIT_V(6); PG8_BAR; PG8_MMA(1, 1, At, B1); PG8_BAR;
            PG8_LDB(B0, 1, 0); PG8_SCHED; PG8_LDA(At, 1, 0); PG8_STAGE(PG8_SA(0, 1), a2 + hstepA, voffA);
            PG8_WAIT_L(8); PG8_BAR; PG8_WAIT_L(0); PG8_MMA(0, 0, At, B0); PG8_BAR; PG8_SCHED;
            PG8_LDB(B1, 1, 1); PG8_STAGE(PG8_SB(1, 0), b3, voffB);
            PG8_BAR; PG8_WAIT_L(0); PG8_MMA(0, 1, At, B1); PG8_BAR;
            PG8_LDA(At, 1, 1); PG8_STAGE(PG8_SA(1, 0), a3, voffA);
            PG8_BAR; PG8_WAIT_L(0); PG8_MMA(1, 0, At, B0); PG8_BAR; PG8_SCHED;
            PG8_STAGE(PG8_SB(1, 1), b3 + hstepB, voffB);
            PG8_WAIT_V(6); PG8_BAR; PG8_MMA(1, 1, At, B1); PG8_BAR;
        }
        E(acc, cur, wr, wc, fr, fq);
        if (!has_next) break;
#pragma unroll
        for (int a = 0; a < 2; ++a)
#pragma unroll
            for (int b = 0; b < 2; ++b)
#pragma unroll
                for (int m = 0; m < 4; ++m)
#pragma unroll
                    for (int n = 0; n < 2; ++n) acc[a][b][m][n] = (f32x4){0.f, 0.f, 0.f, 0.f};
        cur = nxt; cA = nA; cB = nB; ++ui;
    }
    PG8_WAIT_V(0);
    if (wr == 0) PG8_BAR;
    PG8_BAR;
#undef PG8_SA
#undef PG8_SB
#undef PG8_STAGE
#undef PG8_LDA
#undef PG8_LDB
#undef PG8_MMA
#undef PG8_WAIT_V
#undef PG8_WAIT_L
#undef PG8_BAR
#undef PG8_SCHED
}
}
using pg8::Unit;

DI int unit_index(int i, int G, int c) { return G == 256 ? ((i * 8 + (c & 7)) * 32 + (c >> 3)) : (i * G + c); }
DI void band_decode(int U, int nM, int nN, int& pm, int& pn) { const int band = U / (4 * nN), rem = U - band * 4 * nN; const int rows = (nM - 4 * band) < 4 ? (nM - 4 * band) : 4; pn = rem / rows; pm = 4 * band + (rem - pn * rows); }
struct SchedIn {
    const char* H; const char* W; int G, c, base, limit;
    DI bool next(int i, Unit& u) const {
        const int L = base + unit_index(i, G, c); if (L >= limit) return false;
        if (L < 693) { int pm, j; band_decode(L, 33, 21, pm, j); const int pn = j < 8 ? j : j + 4; u.kind = 0; u.nt = DM / 64; u.pm = pm; u.pn = pn; u.a = H + (size_t)pm * 256 * DM * 2; u.b = W + (size_t)pn * 256 * DM * 2; }
        else { const int r = L - 693, i4 = r & 3, j = r >> 2; u.kind = 1; u.nt = DM / 64; u.pm = i4; u.pn = j; u.a = W + (size_t)(2048 + 256 * i4) * DM * 2; u.b = H + (size_t)j * 256 * DM * 2; }
        return true;
    }
};
struct SchedPlain { const char* A; const char* B; int G, c, nM, nN, total, ntK, nfull; size_t astep, bstep;
    DI bool next(int i, Unit& u) const {
        const int L = unit_index(i, G, c); if (L >= total) return false;
        if (L < nfull) { int pm, pn; band_decode(L, nM, nN, pm, pn); u.kind = 0; u.nt = ntK; u.pm = pm; u.pn = pn; u.a = A + (size_t)pm * astep; u.b = B + (size_t)pn * bstep; }
        else { const int s = L - nfull, pn = s % nN, ks = s / nN; u.kind = 2; u.nt = 4; u.pm = 32; u.pn = pn; u.ks = ks; u.a = A + (size_t)32 * astep + (size_t)ks * 512; u.b = B + (size_t)pn * bstep + (size_t)ks * 512; }
        return true;
    }
};
struct EpiIn { static constexpr bool PERM = true; bf16_t* QK; bf16_t* VT; bf16_t* ZR;
    DI void operator()(const f32x4 (&acc)[2][2][4][2], const Unit& u, int wr, int wc, int fr, int fq) const {
        bf16_t* base; int ldc, colt; const int rowt = u.pm * 256;
        if (u.kind == 0) { if (u.pn < 8) { base = QK; ldc = 2048; colt = u.pn * 256; } else { base = ZR; ldc = DSH; colt = (u.pn - 12) * 256; } }
        else { base = VT; ldc = MPAD; colt = u.pn * 256; }
        const int row0 = rowt + wr * 64 + fr, col0 = colt + wc * 32 + 8 * fq;
#pragma unroll
        for (int ai = 0; ai < 2; ++ai)
#pragma unroll
            for (int m = 0; m < 4; ++m) { bf16_t* rowp = base + (size_t)(row0 + ai * 128 + m * 16) * ldc + col0;
#pragma unroll
                for (int bj = 0; bj < 2; ++bj) { const f32x4 v0 = acc[ai][bj][m][0], v1 = acc[ai][bj][m][1];
                    u32x4 o; o.x = pk2(v0[0], v0[1]); o.y = pk2(v0[2], v0[3]); o.z = pk2(v1[0], v1[1]); o.w = pk2(v1[2], v1[3]);
                    *(u32x4*)(rowp + bj * 128) = o; } }
    }
};
struct EpiUp { static constexpr bool PERM = true; bf16_t* GV;
    DI void operator()(const f32x4 (&acc)[2][2][4][2], const Unit& u, int wr, int wc, int fr, int fq) const {
        const int row0 = u.pm * 256 + wr * 64 + fr, col0 = u.pn * 256 + wc * 32 + 8 * fq;
#pragma unroll
        for (int ai = 0; ai < 2; ++ai)
#pragma unroll
            for (int m = 0; m < 4; ++m) { bf16_t* rowp = GV + (size_t)(row0 + ai * 128 + m * 16) * (2 * DFF) + col0;
#pragma unroll
                for (int bj = 0; bj < 2; ++bj) { const f32x4 v0 = acc[ai][bj][m][0], v1 = acc[ai][bj][m][1];
                    u32x4 o; o.x = pk2(v0[0], v0[1]); o.y = pk2(v0[2], v0[3]); o.z = pk2(v1[0], v1[1]); o.w = pk2(v1[2], v1[3]);
                    __builtin_nontemporal_store(o, (u32x4*)(rowp + bj * 128)); } }
    }
};
struct EpiNull { static constexpr bool PERM = false; float* sink;
    DI void operator()(const f32x4 (&acc)[2][2][4][2], const Unit& u, int wr, int wc, int fr, int fq) const { if (acc[0][0][0][0][0] == 123456.789f) sink[0] = 1.f; }
};
template <bool RMW> struct EpiRes { static constexpr bool PERM = false; float* out; const float* xp; const float* xs; const float* MOD; int goff; float* slab;
    DI void operator()(const f32x4 (&acc)[2][2][4][2], const Unit& u, int wr, int wc, int fr, int fq) const {
        const int row0 = u.pm * 256 + wr * 64 + fr, col0 = u.pn * 256 + wc * 32 + 4 * fq;
#pragma unroll
        for (int ai = 0; ai < 2; ++ai)
#pragma unroll
            for (int m = 0; m < 4; ++m) { const int row = row0 + ai * 128 + m * 16;
                if (row < MT) {
                    const int b = row < MPR ? (row >> 11) : 4 + ((row - MPR) >> 4);
                    const float* gp = MOD + (size_t)b * NMOD + goff + col0;
                    float* op = out + (size_t)row * DM + col0;
                    const float* xr = RMW ? op : (row < MPR ? xp + (size_t)row * DM + col0 : xs + (size_t)(row - MPR) * DM + col0);
#pragma unroll
                    for (int bj = 0; bj < 2; ++bj)
#pragma unroll
                        for (int n = 0; n < 2; ++n) { const int o = bj * 128 + n * 16;
                            const f32x4 gv = *(const f32x4*)(gp + o); const f32x4 xv = __builtin_nontemporal_load((const f32x4*)(xr + o));
                            if (u.kind == 2) *(f32x4*)(slab + ((size_t)u.ks * MS + (row - MPR)) * DM + col0 + o) = acc[ai][bj][m][n];
                            else if (RMW) __builtin_nontemporal_store(xv + gv * acc[ai][bj][m][n], (f32x4*)(op + o));
                            else *(f32x4*)(op + o) = xv + gv * acc[ai][bj][m][n]; } } }
    }
};

DI void transpose_item(const float* W, int N, bf16_t* WT, int ldt, int coloff, LAS float* scr, int item, int lane) {
    const int nblk = N / 32, kb = item / nblk, nb = item % nblk, k0 = 64 * kb, n0 = 32 * nb;
#pragma unroll 8
    for (int i = 0; i < 32; ++i) { const int kk = 2 * i + (lane >> 5); scr[kk * 33 + (lane & 31)] = __builtin_nontemporal_load(W + (size_t)(k0 + kk) * N + n0 + (lane & 31)); }
    asm volatile("s_waitcnt lgkmcnt(0)" ::: "memory");
    const int c = lane & 7;
#pragma unroll
    for (int j = 0; j < 4; ++j) { const int n = (lane >> 3) + 8 * j; const LAS float* s = scr + (8 * c) * 33 + n;
        u32x4 o; o.x = pk2(s[0 * 33], s[1 * 33]); o.y = pk2(s[2 * 33], s[3 * 33]); o.z = pk2(s[4 * 33], s[5 * 33]); o.w = pk2(s[6 * 33], s[7 * 33]);
        *(u32x4*)(WT + (size_t)(n0 + n) * ldt + coloff + k0 + 8 * c) = o; }
    asm volatile("s_waitcnt lgkmcnt(0)" ::: "memory");
}
DI void phase0(const Params& p, LAS unsigned char* lds, const int tid_o) {
    const int tid = tid_o, wave = tid >> 6, lane = tid & 63, blk = blockIdx.x, G = gridDim.x;
    unsigned char* ws = p.ws;
    if (blk == 0 && tid < 64) ((unsigned*)(ws + WS_CTR))[64 + tid] = 0u;
    LAS float* sc = (LAS float*)lds;
    LAS float* red = (LAS float*)(lds + 12288);
    float* MODP = (float*)(ws + WS_MODP);
    const float* w_ada = p.in[I_WADA];
    for (int tile = blk; tile < 384; tile += G) {
        const int ct = tile % 48, kc = tile / 48;
        __syncthreads();
        for (int i = tid; i < 3072; i += 512) { const int r = i >> 8, kk = i & 255;
            const float cv = r < 4 ? p.in[I_CP][r * DM + kc * 256 + kk] : p.in[I_CS][(r - 4) * DM + kc * 256 + kk];
            sc[i] = cv / (1.f + __expf(-cv)); }
        __syncthreads();
        f32x4 acc[12];
#pragma unroll
        for (int r = 0; r < 12; ++r) acc[r] = (f32x4){0.f, 0.f, 0.f, 0.f};
        const float* wp = w_ada + (size_t)(kc * 256 + wave * 32) * NMOD + ct * 256 + lane * 4;
#pragma unroll 4
        for (int k = 0; k < 32; ++k) { const f32x4 wv = __builtin_nontemporal_load((const f32x4*)(wp + (size_t)k * NMOD));
#pragma unroll
            for (int r = 0; r < 12; ++r) acc[r] += sc[r * 256 + wave * 32 + k] * wv; }
#pragma unroll
        for (int r = 0; r < 12; ++r) *(LAS f32x4*)(red + (wave * 12 + r) * 256 + lane * 4) = acc[r];
        __syncthreads();
        for (int i = tid; i < 3072; i += 512) { const int r = i >> 8, cc = i & 255; float s = 0.f;
#pragma unroll
            for (int w = 0; w < 8; ++w) s += red[(w * 12 + r) * 256 + cc];
            MODP[(size_t)(kc * 12 + r) * NMOD + ct * 256 + cc] = s; }
    }
    __syncthreads();
    LAS float* scr = (LAS float*)(lds + wave * 16384);
    const int gw = blk * 8 + wave, NGW = G * 8;
    constexpr int I_IN = 32 * 200, I_OUT = 32 * 64, I_UP = 32 * 352, I_DN = 88 * 64, I_L = 32;
    constexpr int NITEMS = I_IN + I_OUT + I_UP + I_DN + 4 * I_L;
    for (int it = gw; it < NITEMS; it += NGW) {
        int r = it;
        if (r < I_IN) { transpose_item(p.in[I_WIN], DIN, (bf16_t*)(ws + WS_WT_IN), DM, 0, scr, r, lane); continue; } r -= I_IN;
        if (r < I_OUT) { transpose_item(p.in[I_WOUT], DM, (bf16_t*)(ws + WS_WT_OUT), DM, 0, scr, r, lane); continue; } r -= I_OUT;
        if (r < I_UP) { transpose_item(p.in[I_WUP], 2 * DFF, (bf16_t*)(ws + WS_WT_UP), DM, 0, scr, r, lane); continue; } r -= I_UP;
        if (r < I_DN) { transpose_item(p.in[I_WDN], DM, (bf16_t*)(ws + WS_WT_DOWN), DFF, 0, scr, r, lane); continue; } r -= I_DN;
        if (r < I_L) { transpose_item(p.in[I_W2], 1024, (bf16_t*)(ws + WS_LT), 256, 0, scr, r, lane); continue; } r -= I_L;
        if (r < I_L) { transpose_item(p.in[I_A2], 1024, (bf16_t*)(ws + WS_LT), 256, 64, scr, r, lane); continue; } r -= I_L;
        transpose_item(p.in[I_G2], 1024, (bf16_t*)(ws + WS_LT), 256, 128, scr, r, lane);
    }
}

DI void deferred_convert(const Params& p, LAS unsigned char* lds, const int tid_o) {
    const int wave = __builtin_amdgcn_readfirstlane(tid_o >> 6), lane = tid_o & 63;
    unsigned char* ws = p.ws; unsigned* ctr = (unsigned*)(ws + WS_CTR) + 64;
    LAS float* scr = (LAS float*)(lds + wave * 16384);
    constexpr int I_OUT = 32 * 64, I_UP = 32 * 352, I_DN = 88 * 64;
    for (;;) { unsigned t = 0; if (lane == 0) t = atomicAdd(ctr, 1u); int r = (int)__builtin_amdgcn_readfirstlane(t); if (r >= I_OUT + I_UP + I_DN) break;
        if (r < I_OUT) { transpose_item(p.in[I_WOUT], DM, (bf16_t*)(ws + WS_WT_OUT), DM, 0, scr, r, lane); continue; } r -= I_OUT;
        if (r < I_UP) { transpose_item(p.in[I_WUP], 2 * DFF, (bf16_t*)(ws + WS_WT_UP), DM, 0, scr, r, lane); continue; } r -= I_UP;
        transpose_item(p.in[I_WDN], DM, (bf16_t*)(ws + WS_WT_DOWN), DFF, 0, scr, r, lane); }
}

template <int WHICH> DI void phase_norm(const Params& p, LAS unsigned char* lds, const int tid_o) {
    const int tid = tid_o, wave = tid >> 6, lane = tid & 63, blk = blockIdx.x, G = gridDim.x;
    unsigned char* ws = p.ws;
    const float* MODP = (const float*)(ws + WS_MODP); float* MOD = (float*)(ws + WS_MOD);
    const float* b_ada = p.in[I_BADA];
    if (WHICH == 0) {
        for (int r = blk; r < 12; r += G)
            for (int j = tid; j < NMOD; j += 512) { float s = b_ada[j];
#pragma unroll
                for (int pp = 0; pp < 8; ++pp) s += MODP[(size_t)(pp * 12 + r) * NMOD + j];
                MOD[(size_t)r * NMOD + j] = s; }
    }
    LAS float* Al = (LAS float*)lds; LAS float* Bl = Al + DM;
    const float* gamma = WHICH == 0 ? p.in[I_NAG] : p.in[I_NFG];
    bf16_t* H = (bf16_t*)(ws + WS_H);
    for (int chunk = blk; chunk < 264; chunk += G) {
        const int b = chunk < 256 ? (chunk >> 6) : 4 + (chunk - 256);
        __syncthreads();
        for (int j = tid; j < DM; j += 512) { float scv, shv;
            if (WHICH == 0) { scv = b_ada[DM + j]; shv = b_ada[j];
#pragma unroll
                for (int pp = 0; pp < 8; ++pp) { scv += MODP[(size_t)(pp * 12 + b) * NMOD + DM + j]; shv += MODP[(size_t)(pp * 12 + b) * NMOD + j]; } }
            else { scv = MOD[(size_t)b * NMOD + 4 * DM + j]; shv = MOD[(size_t)b * NMOD + 3 * DM + j]; }
            Al[j] = gamma[j] * (1.f + scv); Bl[j] = shv; }
        __syncthreads();
        const int nrows = chunk < 256 ? 32 : 16, row0 = chunk < 256 ? chunk * 32 : MPR + (chunk - 256) * 16;
        if (WHICH == 1 && chunk >= 256) {
            const float* slab = (const float*)(ws + WS_FV);
            for (int i = tid; i < 16 * DM / 4; i += 512) { const int r = i >> 9, c4 = (i & 511) * 4; const int m = row0 + r; f32x4 sum = (f32x4){0.f, 0.f, 0.f, 0.f};
#pragma unroll
                for (int ks = 0; ks < 8; ++ks) sum += *(const f32x4*)(slab + ((size_t)ks * MS + (m - MPR)) * DM + c4);
                const f32x4 g = *(const f32x4*)(MOD + (size_t)b * NMOD + 2 * DM + c4); f32x4* op = (f32x4*)(p.out + (size_t)m * DM + c4); *op = *op + g * sum; }
            __syncthreads();
        }
        const int nr = nrows >> 3;
        for (int rp = 0; rp < nr; rp += 2) {
            f32x4 v[2][8]; float ss[2] = {0.f, 0.f};
#pragma unroll
            for (int q = 0; q < 2; ++q) { const int m = row0 + wave + 8 * (rp + q);
                const float* xr = WHICH == 0 ? (m < MPR ? p.in[I_XP] + (size_t)m * DM : p.in[I_XS] + (size_t)(m - MPR) * DM) : p.out + (size_t)m * DM;
#pragma unroll
                for (int j = 0; j < 8; ++j) v[q][j] = __builtin_nontemporal_load((const f32x4*)(xr + j * 256 + lane * 4)); }
#pragma unroll
            for (int q = 0; q < 2; ++q) {
#pragma unroll
                for (int j = 0; j < 8; ++j) ss[q] += v[q][j].x * v[q][j].x + v[q][j].y * v[q][j].y + v[q][j].z * v[q][j].z + v[q][j].w * v[q][j].w; }
#pragma unroll
            for (int q = 0; q < 2; ++q) { const int m = row0 + wave + 8 * (rp + q);
                const float rstd = rsqrtf(wave_sum(ss[q]) * (1.f / DM) + 1e-6f);
#pragma unroll
                for (int j = 0; j < 8; ++j) { const int idx = j * 256 + lane * 4; const f32x4 a4 = *(const LAS f32x4*)(Al + idx), b4 = *(const LAS f32x4*)(Bl + idx);
                    const f32x4 o = v[q][j] * rstd * a4 + b4; u32x2 qq; qq.x = pk2(o.x, o.y); qq.y = pk2(o.z, o.w);
                    *(u32x2*)(H + (size_t)m * DM + idx) = qq; } }
        }
    }
}

DI void load_zs(const Params& p, const bf16_t* ZR, int m, int c, int n, float* o) {
    const bool samp = m >= MPR; const int t = samp ? ((m - MPR) & 15) : (m & (SEQ - 1)); const int bs = samp ? ((m - MPR) >> 4) : 0;
    const int mp = t > 0 ? m - 1 : m;
    float z[8], zp[8], st[8];
    if (n == 8) { unpack8(*(const u32x4*)(ZR + (size_t)m * DSH + c), z); unpack8(*(const u32x4*)(ZR + (size_t)mp * DSH + c), zp);
        const f32x4 s0 = *(const f32x4*)(p.in[I_SS] + (size_t)bs * DSH + c), s1 = *(const f32x4*)(p.in[I_SS] + (size_t)bs * DSH + c + 4);
        st[0] = s0.x; st[1] = s0.y; st[2] = s0.z; st[3] = s0.w; st[4] = s1.x; st[5] = s1.y; st[6] = s1.z; st[7] = s1.w; }
    else { unpack4(*(const u32x2*)(ZR + (size_t)m * DSH + c), z); unpack4(*(const u32x2*)(ZR + (size_t)mp * DSH + c), zp);
        const f32x4 s0 = *(const f32x4*)(p.in[I_SS] + (size_t)bs * DSH + c); st[0] = s0.x; st[1] = s0.y; st[2] = s0.z; st[3] = s0.w; }
    const float* mu = p.in[I_MU] + c;
#pragma unroll
    for (int j = 0; j < n; ++j) { const float pv = t > 0 ? zp[j] : (samp ? st[j] : 0.f); o[j] = z[j] + (pv - z[j]) * mu[j]; }
}
DI void phase_prep(const Params& p, LAS unsigned char* lds, const int tid_o) {
    const int tid = tid_o, wave = tid >> 6, lane = tid & 63, blk = blockIdx.x, G = gridDim.x;
    unsigned char* ws = p.ws; float* out = p.out;
    bf16_t* QK = (bf16_t*)(ws + WS_QK); const bf16_t* VT = (const bf16_t*)(ws + WS_VT); const bf16_t* ZR = (const bf16_t*)(ws + WS_ZR);
    const int gw = blk * 8 + wave, NGW = G * 8;
    if (blk == 0 && tid >= 128 && tid < 256) ((unsigned*)(ws + WS_CTR))[tid] = 0u;
    if (G == 256) {
        SchedIn S; S.H = (const char*)(ws + WS_H); S.W = (const char*)(ws + WS_WT_IN); S.G = G; S.c = blk; S.base = 768; S.limit = 825;
        EpiIn E; E.QK = (bf16_t*)(ws + WS_QK); E.VT = (bf16_t*)(ws + WS_VT); E.ZR = (bf16_t*)(ws + WS_ZR);
        pg8::gemm_phase(lds, pg8::GemmK{DM, DM, DM}, S, E, tid_o);
        __syncthreads();
    }
    for (int m = gw; m < MT; m += NGW) {
        int lane_o = lane; asm volatile("" : "+v"(lane_o));
#pragma unroll
        for (int it = 0; it < 4; ++it) { const int col = it * 512 + lane_o * 8;
            float x[8]; unpack8(*(const u32x4*)(QK + (size_t)m * 2048 + col), x);
            float ss = 0.f;
#pragma unroll
            for (int j = 0; j < 8; ++j) ss += x[j] * x[j];
            ss += __shfl_xor(ss, 1); ss += __shfl_xor(ss, 2); ss += __shfl_xor(ss, 4);
            const float rstd = rsqrtf(ss * (1.f / 64.f) + 1e-6f);
            const bool isk = col >= 1024; const float* g = (isk ? p.in[I_KG] : p.in[I_QG]) + (col & 63);
            float y[8];
#pragma unroll
            for (int j = 0; j < 8; ++j) y[j] = x[j] * rstd * g[j];
            if (isk) {
                const int hc = col - 1024;
                float* op = nullptr;
                if (m >= MPR) op = out + O_KS + (size_t)(m - MPR) * 1024 + hc;
                else { const int t = m & (SEQ - 1), b = m >> 11; if (t >= SEQ - 512) op = out + O_KP + ((size_t)b * 512 + (t - (SEQ - 512))) * 1024 + hc; }
                if (op) { *(f32x4*)op = (f32x4){y[0], y[1], y[2], y[3]}; *(f32x4*)(op + 4) = (f32x4){y[4], y[5], y[6], y[7]}; }
            } else {
#pragma unroll
                for (int j = 0; j < 8; ++j) y[j] *= 0.125f;
            }
            u32x4 o; o.x = pk2(y[0], y[1]); o.y = pk2(y[2], y[3]); o.z = pk2(y[4], y[5]); o.w = pk2(y[6], y[7]);
            *(u32x4*)(QK + (size_t)m * 2048 + col) = o; }
    }
#if REPEAT_SUB == 3
    for (int rep3 = 0; rep3 < 2; ++rep3) {
#else
    {
#endif
    { bf16_t* KC = (bf16_t*)(ws + WS_KC); bf16_t* VTC = (bf16_t*)(ws + WS_VTC);
      for (int i = blk * 512 + tid; i < 8 * 512 * 1024 / 8; i += G * 512) { const f32x4 a0 = __builtin_nontemporal_load((const f32x4*)(p.in[I_CK] + (size_t)i * 8)), a1 = __builtin_nontemporal_load((const f32x4*)(p.in[I_CK] + (size_t)i * 8 + 4));
          u32x4 o; o.x = pk2(a0.x, a0.y); o.y = pk2(a0.z, a0.w); o.z = pk2(a1.x, a1.y); o.w = pk2(a1.z, a1.w); *(u32x4*)(KC + (size_t)i * 8) = o; }
      for (int task = gw; task < 8 * 16 * 8; task += NGW) { const int jb = task & 7, cb = (task >> 3) & 15, b = task >> 7; const int c = cb * 64 + lane;
          float v[64];
#pragma unroll
          for (int j = 0; j < 64; ++j) v[j] = __builtin_nontemporal_load(p.in[I_CV] + ((size_t)b * 512 + jb * 64 + j) * 1024 + c);
#pragma unroll
          for (int q = 0; q < 8; ++q) { u32x4 o; o.x = pk2(v[8 * q], v[8 * q + 1]); o.y = pk2(v[8 * q + 2], v[8 * q + 3]); o.z = pk2(v[8 * q + 4], v[8 * q + 5]); o.w = pk2(v[8 * q + 6], v[8 * q + 7]);
              *(u32x4*)(VTC + ((size_t)b * 1024 + c) * 512 + jb * 64 + 8 * q) = o; } }
    }
    { const size_t gt = (size_t)blk * 512 + tid, NT = (size_t)G * 512;
      for (size_t i = gt; i < (size_t)12 * DSH; i += NT) { const int r = (int)(i / DSH), c = (int)(i % DSH);
          if (r < 4) out[O_SHP + (size_t)r * DSH + c] = bf1(ZR[(size_t)(r * SEQ + SEQ - 1) * DSH + c]);
          else out[O_SHS + (size_t)(r - 4) * DSH + c] = bf1(ZR[(size_t)(MPR + (r - 4) * 16 + 15) * DSH + c]); }
    }
    const bf16_t* LT = (const bf16_t*)(ws + WS_LT);
    float* FW = (float*)(ws + WS_FW); bf16_t* FB = (bf16_t*)(ws + WS_FB); bf16_t* FV = (bf16_t*)(ws + WS_FV); bf16_t* GG = (bf16_t*)(ws + WS_GG); float* BON = (float*)(ws + WS_BONUS);
    const float* SSH = p.in[I_SS]; const float* MU = p.in[I_MU];
    LAS unsigned char* Ap = lds;
    LAS bf16_t* zt = (LAS bf16_t*)(lds + 16896 + wave * 13200);
    const int n0 = lane & 31, hf0 = lane >> 5;
    for (;;) {
        LAS int* tslot = (LAS int*)(lds + 130944);
        __syncthreads();
        if (tid == 0) *tslot = (int)atomicAdd((unsigned*)(ws + WS_CTR) + 64, 1u);
        __syncthreads();
        const int task = *tslot; if (task >= 520) break;
        const int m0 = (task >> 1) * 32; const bool samp = m0 >= MPR;
        int hf = hf0; asm volatile("" : "+v"(hf));
        __syncthreads();
        {
            const int tk = tid >> 4, cc = (tid & 15) * 16; const int m = m0 + tk;
            const int t = samp ? ((m - MPR) & 15) : (m & (SEQ - 1)); const int bs = samp ? ((m - MPR) >> 4) : 0; const int mp = t > 0 ? m - 1 : m;
            float z[16], zp[16];
            unpack8(*(const u32x4*)(ZR + (size_t)m * DSH + 3072 + cc), z); unpack8(*(const u32x4*)(ZR + (size_t)m * DSH + 3072 + cc + 8), z + 8);
            unpack8(*(const u32x4*)(ZR + (size_t)mp * DSH + 3072 + cc), zp); unpack8(*(const u32x4*)(ZR + (size_t)mp * DSH + 3072 + cc + 8), zp + 8);
            float o[16];
#pragma unroll
            for (int j4 = 0; j4 < 4; ++j4) { const f32x4 mu4 = *(const f32x4*)(MU + 3072 + cc + 4 * j4), st4 = *(const f32x4*)(SSH + (size_t)bs * DSH + 3072 + cc + 4 * j4);
#pragma unroll
                for (int e = 0; e < 4; ++e) { const int j = 4 * j4 + e; const float pv = t > 0 ? zp[j] : (samp ? st4[e] : 0.f); float v = z[j] + (pv - z[j]) * mu4[e];
                    if (cc < 64) v = 1.f - 2.f / (1.f + __expf(2.f * v)); else if (cc >= 128) v = sigmoidf_(v);
                    o[j] = v; } }
            u32x4 q0, q1; q0.x = pk2(o[0], o[1]); q0.y = pk2(o[2], o[3]); q0.z = pk2(o[4], o[5]); q0.w = pk2(o[6], o[7]); q1.x = pk2(o[8], o[9]); q1.y = pk2(o[10], o[11]); q1.z = pk2(o[12], o[13]); q1.w = pk2(o[14], o[15]);
            *(LAS u32x4*)(Ap + tk * 528 + cc * 2) = q0; *(LAS u32x4*)(Ap + tk * 528 + cc * 2 + 16) = q1;
        }
        __syncthreads();
        bf16x8 Bf[16];
#pragma unroll
        for (int s = 0; s < 16; ++s) Bf[s] = *(const LAS bf16x8*)(Ap + n0 * 528 + (16 * s + 8 * hf) * 2);
#pragma unroll 1
        for (int hh = (task & 1); hh <= (task & 1); ++hh) { const int h = wave * 2 + hh;
            int n = n0; asm volatile("" : "+v"(hf), "+v"(n));
            for (int q = lane; q < 33 * 24; q += 64) { const int row = q / 24, seg = q - row * 24, vec = seg >> 3, part = seg & 7; int mr = m0 - 1 + row; mr = mr < 0 ? 0 : mr;
                *(LAS u32x4*)(zt + row * 200 + vec * 64 + part * 8) = *(const u32x4*)(ZR + (size_t)mr * DSH + vec * 1024 + h * 64 + part * 8); }
#pragma unroll 1
            for (int b2 = 0; b2 < 2; ++b2) { f32x16 ag; for (int i = 0; i < 16; ++i) ag[i] = 0.f;
                const int c = h * 64 + b2 * 32 + n; const bf16_t* lt = LT + (size_t)c * 256 + 8 * hf;
#pragma unroll
                for (int s = 8; s < 16; ++s) ag = MFMA32(Bf[s], *(const bf16x8*)(lt + 16 * s), ag);
#pragma unroll
                for (int i = 0; i < 16; ++i) GG[(size_t)(m0 + crow(i, hf)) * 1024 + c] = (bf16_t)(pk2(ag[i], 0.f) & 0xffffu); }
#define ZS(vec, cl, i, muv, stv) ({ const int ti_ = crow(i, hf); const float z_ = bf1(zt[(ti_ + 1) * 200 + (vec) * 64 + (cl)]); float pv_ = bf1(zt[ti_ * 200 + (vec) * 64 + (cl)]); \
                if ((i) == 0 || (i) == 8) { const int m_ = m0 + ti_; const int t_ = samp ? ((m_ - MPR) & 15) : (m_ & (SEQ - 1)); if (t_ == 0) pv_ = samp ? (stv) : 0.f; } z_ + (pv_ - z_) * (muv); })
            float ssq[16];
#pragma unroll
            for (int i = 0; i < 16; ++i) ssq[i] = 0.f;
#pragma unroll
            for (int b2 = 0; b2 < 2; ++b2) { const int cl = b2 * 32 + n, c = h * 64 + cl; const float kkw = p.in[I_KK][c], muk = MU[1024 + c];
                const int bs0 = samp ? ((m0 - MPR) >> 4) : 0; const float st0 = SSH[(size_t)bs0 * DSH + 1024 + c], st1 = SSH[(size_t)(samp ? bs0 + 1 : 0) * DSH + 1024 + c];
#pragma unroll
                for (int i = 0; i < 16; ++i) { const float kv = ZS(1, cl, i, muk, (i == 0 ? st0 : st1)); const float q = kv * kkw; ssq[i] += q * q; } }
            float inv[16];
#pragma unroll
            for (int i = 0; i < 16; ++i) { float v = row16_sum(ssq[i]); v += __shfl_xor(v, 16); inv[i] = 1.f / fmaxf(sqrtf(v), 1e-12f); }
            float bon[16];
#pragma unroll
            for (int i = 0; i < 16; ++i) bon[i] = 0.f;
#pragma unroll 1
            for (int b2 = 0; b2 < 2; ++b2) { asm volatile("" : "+v"(hf), "+v"(n)); const int cl = b2 * 32 + n, c = h * 64 + cl;
                f32x16 aw, aa; for (int i = 0; i < 16; ++i) { aw[i] = 0.f; aa[i] = 0.f; }
                const bf16_t* lt = LT + (size_t)c * 256 + 8 * hf;
#pragma unroll
                for (int s = 0; s < 4; ++s) aw = MFMA32(Bf[s], *(const bf16x8*)(lt + 16 * s), aw);
#pragma unroll
                for (int s = 4; s < 8; ++s) aa = MFMA32(Bf[s], *(const bf16x8*)(lt + 16 * s), aa);
                const float w0 = p.in[I_W0][c], a0 = p.in[I_A0][c], kkw = p.in[I_KK][c], kaw = p.in[I_KA][c], rkw = p.in[I_RK][c], mur = MU[c], muk = MU[1024 + c], muv = MU[2048 + c];
                const int bs0 = samp ? ((m0 - MPR) >> 4) : 0, bs1 = samp ? bs0 + 1 : 0;
                const float sr0 = SSH[(size_t)bs0 * DSH + c], sr1 = SSH[(size_t)bs1 * DSH + c], sk0 = SSH[(size_t)bs0 * DSH + 1024 + c], sk1 = SSH[(size_t)bs1 * DSH + 1024 + c], sv0 = SSH[(size_t)bs0 * DSH + 2048 + c], sv1 = SSH[(size_t)bs1 * DSH + 2048 + c];
#pragma unroll
                for (int i = 0; i < 16; ++i) { const int m = m0 + crow(i, hf);
                    const float rz = ZS(0, cl, i, mur, (i == 0 ? sr0 : sr1)), kv = ZS(1, cl, i, muk, (i == 0 ? sk0 : sk1)), vz = ZS(2, cl, i, muv, (i == 0 ? sv0 : sv1));
                    const float wl = w0 + aw[i];
                    const float y = -wl; const float sp = fmaxf(y, 0.f) + __logf(1.f + __expf(-fabsf(y)));
                    const float dec = __expf(-__expf(-sp - 0.5f));
                    const float av = sigmoidf_(a0 + aa[i]);
                    const float kk = kv * kkw * inv[i], kp = kv * (1.f + (av - 1.f) * kaw), kka = kk * av;
                    bon[i] += rz * kp * rkw;
                    FW[((size_t)m * 16 + h) * 64 + cl] = dec;
                    bf16_t* fb = FB + ((size_t)m * 16 + h) * 256 + cl;
                    fb[0] = (bf16_t)(pk2(rz, 0.f) & 0xffffu); fb[64] = (bf16_t)(pk2(kp, 0.f) & 0xffffu); fb[128] = (bf16_t)(pk2(kk, 0.f) & 0xffffu); fb[192] = (bf16_t)(pk2(kka, 0.f) & 0xffffu);
                    FV[(size_t)m * 1024 + c] = (bf16_t)(pk2(vz, 0.f) & 0xffffu); __builtin_amdgcn_sched_barrier(0); }
            }
#undef ZS
#pragma unroll
            for (int i = 0; i < 16; ++i) { float v = row16_sum(bon[i]); v += __shfl_xor(v, 16); if (n == 0) BON[(size_t)(m0 + crow(i, hf)) * 16 + h] = v; }
        }
    }
    }
}

constexpr int SC_TC = 16, SC_NB = 4, SC_BUFB = SC_TC * 1280 + SC_TC * 64;
constexpr int L_FLAGS = SC_NB * SC_BUFB, L_TBL = L_FLAGS + 64, L_KV = L_TBL + 8 * 1040, KV_STRIDE = 144, KV_BYTES = 2 * 64 * KV_STRIDE;
DI void scan_run(const Params& p, LAS unsigned char* lds, const int wave, const int lane, const int blk, const int G) {
    unsigned char* ws = p.ws; float* out = p.out;
    const float* FW = (const float*)(ws + WS_FW); const bf16_t* FB = (const bf16_t*)(ws + WS_FB); const bf16_t* FV = (const bf16_t*)(ws + WS_FV); float* Y = (float*)(ws + WS_Y);
    LAS unsigned* ready = (LAS unsigned*)(lds + L_FLAGS); LAS unsigned* done = ready + SC_NB;
    unsigned gc = 0;
    for (int u = blk; u < 768; u += G) {
        int m0, T, h, rg; const float* S0; float* Sout;
        if (u < 256) { const int bh = u >> 2; rg = u & 3; h = bh & 15; m0 = (bh >> 4) * SEQ; T = SEQ; S0 = nullptr; Sout = out + O_SP + (size_t)bh * 4096; }
        else { const int su = u - 256, bh = su >> 2; rg = su & 3; h = bh & 15; m0 = MPR + (bh >> 4) * 16; T = 16; S0 = p.in[I_SR] + (size_t)bh * 4096; Sout = out + O_SS + (size_t)bh * 4096; }
        const int nch = T / SC_TC;
        if (wave >= 4) {
            const int lw = wave - 4; const int cstart = (int)((gc + (unsigned)lw) & 1u); const int nmine = (nch - cstart + 1) >> 1;
            f32x4 fw[3][4]; u32x4 fb[3][8]; u32x4 fv[3];
#define FEED_ISSUE(slot, jidx) do { const int _j = (jidx) < nmine ? (jidx) : nmine - 1; const int _mb = m0 + (cstart + 2 * _j) * SC_TC; \
                _Pragma("unroll") for (int i = 0; i < 4; ++i) { const int idx = i * 64 + lane, st = idx >> 4, q = idx & 15; fw[slot][i] = *(const f32x4*)(FW + ((size_t)(_mb + st) * 16 + h) * 64 + q * 4); } \
                _Pragma("unroll") for (int i = 0; i < 8; ++i) { const int idx = i * 64 + lane, st = idx >> 5, q = idx & 31; fb[slot][i] = *(const u32x4*)(FB + ((size_t)(_mb + st) * 16 + h) * 256 + q * 8); } \
                fv[slot] = *(const u32x4*)(FV + (size_t)(_mb + ((lane & 31) >> 1)) * 1024 + h * 64 + rg * 16 + (lane & 1) * 8); } while (0)
            if (nmine > 0) {
                FEED_ISSUE(0, 0); FEED_ISSUE(1, 1);
                for (int j0 = 0; j0 < nmine; j0 += 3) {
#pragma unroll
                    for (int jj = 0; jj < 3; ++jj) { const int j = j0 + jj;
                        if (j < nmine) {
                            FEED_ISSUE((jj + 2) % 3, j + 2);
                            const unsigned g = gc + (unsigned)(cstart + 2 * j); const int b = g & (SC_NB - 1);
                            if (g >= SC_NB) { const unsigned target = 4u * (g / SC_NB); while (__hip_atomic_load(done + b, __ATOMIC_RELAXED, __HIP_MEMORY_SCOPE_WORKGROUP) < target) __builtin_amdgcn_s_sleep(1); asm volatile("" ::: "memory"); }
                            LAS unsigned char* buf = lds + b * SC_BUFB;
#pragma unroll
                            for (int i = 0; i < 4; ++i) { const int idx = i * 64 + lane, st = idx >> 4, q = idx & 15; *(LAS f32x4*)(buf + st * 1280 + q * 16) = fw[jj][i]; }
#pragma unroll
                            for (int i = 0; i < 8; ++i) { const int idx = i * 64 + lane, st = idx >> 5, q = idx & 31; float f[8]; unpack8(fb[jj][i], f);
                                LAS float* d = (LAS float*)(buf + st * 1280 + 256 + q * 32); *(LAS f32x4*)d = (f32x4){f[0], f[1], f[2], f[3]}; *(LAS f32x4*)(d + 4) = (f32x4){f[4], f[5], f[6], f[7]}; }
                            if (lane < 32) { float f[8]; unpack8(fv[jj], f); LAS float* d = (LAS float*)(buf + SC_TC * 1280 + (lane >> 1) * 64 + (lane & 1) * 32);
                                *(LAS f32x4*)d = (f32x4){f[0], f[1], f[2], f[3]}; *(LAS f32x4*)(d + 4) = (f32x4){f[4], f[5], f[6], f[7]}; }
                            asm volatile("" ::: "memory");
                            if (lane == 0) __hip_atomic_store(ready + b, g + 1u, __ATOMIC_RELAXED, __HIP_MEMORY_SCOPE_WORKGROUP);
                            asm volatile("" ::: "memory");
                        }
                    }
                }
            }
#undef FEED_ISSUE
        } else {
            const int rl = wave * 4 + (lane >> 4), kq = lane & 15, row = rg * 16 + rl;
            f32x2 Sa = (f32x2){0.f, 0.f}, Sb = (f32x2){0.f, 0.f};
            if (S0) { const f32x4 s4 = *(const f32x4*)(S0 + row * 64 + kq * 4); Sa = (f32x2){s4.x, s4.y}; Sb = (f32x2){s4.z, s4.w}; }
            for (int c = 0; c < nch; ++c) { const unsigned g = gc + c; const int b = g & (SC_NB - 1);
                while (__hip_atomic_load(ready + b, __ATOMIC_RELAXED, __HIP_MEMORY_SCOPE_WORKGROUP) < g + 1u) __builtin_amdgcn_s_sleep(1);
                asm volatile("" ::: "memory");
                const LAS unsigned char* buf = lds + b * SC_BUFB;
                float ykeep = 0.f;
                f32x4 W_[3], R_[3], K_[3], KK_[3], KA_[3]; float V_[3];
#define SC_LOAD(slot, st) do { const LAS unsigned char* sb = buf + (st) * 1280 + kq * 16; W_[slot] = *(const LAS f32x4*)(sb); R_[slot] = *(const LAS f32x4*)(sb + 256); K_[slot] = *(const LAS f32x4*)(sb + 512); \
                    KK_[slot] = *(const LAS f32x4*)(sb + 768); KA_[slot] = *(const LAS f32x4*)(sb + 1024); V_[slot] = *(const LAS float*)(buf + SC_TC * 1280 + (st) * 64 + rl * 4); } while (0)
                SC_LOAD(0, 0); SC_LOAD(1, 1); SC_LOAD(2, 2);
#pragma unroll
                for (int st = 0; st < SC_TC; ++st) { const int sl = st % 3;
                    const f32x4 w4 = W_[sl], r4 = R_[sl], k4 = K_[sl], kk4 = KK_[sl], ka4 = KA_[sl]; const float vv = V_[sl];
                    f32x2 p2 = Sa * (f32x2){kk4.x, kk4.y}; p2 = Sb * (f32x2){kk4.z, kk4.w} + p2;
                    float pa = p2.x + p2.y; pa = row16_sum(pa);
                    const f32x2 Ta = Sa * (f32x2){w4.x, w4.y} + vv * (f32x2){k4.x, k4.y}, Tb = Sb * (f32x2){w4.z, w4.w} + vv * (f32x2){k4.z, k4.w};
                    Sa = Ta - pa * (f32x2){ka4.x, ka4.y}; Sb = Tb - pa * (f32x2){ka4.z, ka4.w};
                    f32x2 q2 = Sa * (f32x2){r4.x, r4.y}; q2 = Sb * (f32x2){r4.z, r4.w} + q2;
                    float qy = q2.x + q2.y; qy = row16_sum(qy);
                    ykeep = (kq == st) ? qy : ykeep;
                    if (st + 3 < SC_TC) SC_LOAD(sl, st + 3);
                }
#undef SC_LOAD
                asm volatile("" ::: "memory");
                if (lane == 0) __hip_atomic_fetch_add(done + b, 1u, __ATOMIC_RELAXED, __HIP_MEMORY_SCOPE_WORKGROUP);
                asm volatile("" ::: "memory");
                Y[(size_t)(m0 + c * SC_TC + kq) * 1024 + h * 64 + row] = ykeep;
            }
            *(f32x4*)(Sout + row * 64 + kq * 4) = (f32x4){Sa.x, Sa.y, Sb.x, Sb.y};
        }
        gc += nch;
    }
}

DI void attn_wave_task(const Params& p, LAS float* tbl, LAS unsigned char* kv, const int task, const int lane) {
    unsigned char* ws = p.ws;
    const bf16_t* QK = (const bf16_t*)(ws + WS_QK); const bf16_t* VT = (const bf16_t*)(ws + WS_VT); bf16_t* MIX = (bf16_t*)(ws + WS_MIXIN);
    const int c = 31 - (task >> 7), rem = task & 127, b = rem >> 5, h = (rem >> 1) & 15, half = rem & 1;
    for (int i = lane; i < 257; i += 64) tbl[i] = p.in[I_RB][h * 257 + i] * LOG2E;
    const int n = lane & 31, hf = lane >> 5;
    const int mq = b * SEQ + c * 64 + half * 32 + n;
    bf16x8 Qf[4];
#pragma unroll
    for (int s = 0; s < 4; ++s) Qf[s] = *(const bf16x8*)(QK + (size_t)mq * 2048 + h * 64 + 16 * s + 8 * hf);
    f32x16 O[2]; for (int i = 0; i < 16; ++i) { O[0][i] = 0.f; O[1][i] = 0.f; }
    float mrun = -1e30f, lrun = 0.f;
    const int kc0 = c - 8 < 0 ? 0 : c - 8;
    LAS unsigned char* kt = kv; LAS unsigned char* vt = kv + 64 * KV_STRIDE;
    const int srow = lane >> 3, spc = lane & 7;
    u32x4 kreg[8], vreg[8];
#define KV_FETCH(kcx) do { const bf16_t* kg = QK + (size_t)(b * SEQ + (kcx) * 64 + srow) * 2048 + 1024 + h * 64 + spc * 8; const bf16_t* vg = VT + (size_t)(h * 64 + srow) * MPAD + (size_t)b * SEQ + (kcx) * 64 + spc * 8; \
        _Pragma("unroll") for (int i = 0; i < 8; ++i) { kreg[i] = *(const u32x4*)(kg + (size_t)i * 8 * 2048); vreg[i] = *(const u32x4*)(vg + (size_t)i * 8 * MPAD); } } while (0)
#define KV_STORE() do { _Pragma("unroll") for (int i = 0; i < 8; ++i) { *(LAS u32x4*)(kt + (i * 8 + srow) * KV_STRIDE + spc * 16) = kreg[i]; *(LAS u32x4*)(vt + (i * 8 + srow) * KV_STRIDE + spc * 16) = vreg[i]; } } while (0)
    KV_FETCH(kc0);
    KV_STORE();
    for (int kc = kc0; kc <= c; ++kc) {
        { const int kn = kc < c ? kc + 1 : kc; KV_FETCH(kn); }
        f32x16 Sx[2];
#pragma unroll
        for (int kb = 0; kb < 2; ++kb) { for (int i = 0; i < 16; ++i) Sx[kb][i] = 0.f;
#pragma unroll
            for (int s = 0; s < 4; ++s) Sx[kb] = MFMA32(*(const LAS bf16x8*)(kt + (kb * 32 + n) * KV_STRIDE + 16 * hf + 32 * s), Qf[s], Sx[kb]); }
        const int dist0 = (c - kc) * 64 + half * 32 + n;
        float mx = -1e30f; float ebias = 0.f; const bool far = c - kc >= 3;
        if (far) { ebias = tbl[256];
#pragma unroll
            for (int kb = 0; kb < 2; ++kb)
#pragma unroll
                for (int i = 0; i < 16; ++i) mx = fmaxf(mx, Sx[kb][i]);
            mx = mx * LOG2E + ebias; }
        else {
#pragma unroll
            for (int kb = 0; kb < 2; ++kb)
#pragma unroll
                for (int i = 0; i < 16; ++i) { int rel = dist0 - kb * 32 - crow(i, hf); rel = rel < -128 ? -128 : (rel > 128 ? 128 : rel);
                    Sx[kb][i] = Sx[kb][i] * LOG2E + tbl[rel + 128]; mx = fmaxf(mx, Sx[kb][i]); } }
        mx = fmaxf(mx, __shfl_xor(mx, 32));
        const float mnew = fmaxf(mrun, mx); const float alpha = __builtin_amdgcn_exp2f(mrun - mnew); mrun = mnew;
        float ls = 0.f; const float esc = far ? LOG2E : 1.f, eoff = (far ? ebias : 0.f) - mnew;
#pragma unroll
        for (int kb = 0; kb < 2; ++kb)
#pragma unroll
            for (int i = 0; i < 16; ++i) { Sx[kb][i] = __builtin_amdgcn_exp2f(Sx[kb][i] * esc + eoff); ls += Sx[kb][i]; }
        lrun = lrun * alpha + ls;
#pragma unroll
        for (int i = 0; i < 16; ++i) { O[0][i] *= alpha; O[1][i] *= alpha; }
#pragma unroll
        for (int kb = 0; kb < 2; ++kb)
#pragma unroll
            for (int s2 = 0; s2 < 2; ++s2) {
                u32x4 pp; pp.x = pk2(Sx[kb][8 * s2], Sx[kb][8 * s2 + 1]); pp.y = pk2(Sx[kb][8 * s2 + 2], Sx[kb][8 * s2 + 3]); pp.z = pk2(Sx[kb][8 * s2 + 4], Sx[kb][8 * s2 + 5]); pp.w = pk2(Sx[kb][8 * s2 + 6], Sx[kb][8 * s2 + 7]);
                const bf16x8 Pf = __builtin_bit_cast(bf16x8, pp);
#pragma unroll
                for (int db = 0; db < 2; ++db) { const LAS unsigned char* vp = vt + (db * 32 + n) * KV_STRIDE + (kb * 32 + 16 * s2 + 4 * hf) * 2;
                    const s16x4 lo = *(const LAS s16x4*)vp, hi = *(const LAS s16x4*)(vp + 16);
                    const bf16x8 Vf = __builtin_shufflevector(lo, hi, 0, 1, 2, 3, 4, 5, 6, 7);
                    O[db] = MFMA32(Vf, Pf, O[db]); } }
        asm volatile("" ::: "memory");
        KV_STORE();
        asm volatile("" ::: "memory");
    }
#undef KV_FETCH
#undef KV_STORE
    const float l = lrun + __shfl_xor(lrun, 32); const float inv = 1.f / l;
#pragma unroll
    for (int db = 0; db < 2; ++db)
#pragma unroll
        for (int g4 = 0; g4 < 4; ++g4) { const int d0 = db * 32 + 8 * g4 + 4 * hf; u32x2 o; o.x = pk2(O[db][4 * g4] * inv, O[db][4 * g4 + 1] * inv); o.y = pk2(O[db][4 * g4 + 2] * inv, O[db][4 * g4 + 3] * inv);
            *(u32x2*)(MIX + (size_t)mq * 2048 + h * 64 + d0) = o; }
}

DI void attn_sample_wave(const Params& p, LAS float* tbl, const int bh, const int lane) {
    unsigned char* ws = p.ws;
    const bf16_t* QK = (const bf16_t*)(ws + WS_QK); const bf16_t* VT = (const bf16_t*)(ws + WS_VT); bf16_t* MIX = (bf16_t*)(ws + WS_MIXIN);
    const bf16_t* KC = (const bf16_t*)(ws + WS_KC); const bf16_t* VTC = (const bf16_t*)(ws + WS_VTC);
    const int b = bh >> 4, h = bh & 15;
    for (int i = lane; i < 257; i += 64) tbl[i] = p.in[I_RB][h * 257 + i] * LOG2E;
    const int n = lane & 31, hf = lane >> 5, qi = n & 15;
    const int mq = MPR + b * 16 + qi;
    bf16x8 Qf[4];
#pragma unroll
    for (int s = 0; s < 4; ++s) Qf[s] = *(const bf16x8*)(QK + (size_t)mq * 2048 + h * 64 + 16 * s + 8 * hf);
    f32x16 O[2]; for (int i = 0; i < 16; ++i) { O[0][i] = 0.f; O[1][i] = 0.f; }
    float mrun = -1e30f, lrun = 0.f;
#pragma unroll 1
    for (int kc = 0; kc < 9; ++kc) {
        f32x16 Sx[2];
#pragma unroll
        for (int kb = 0; kb < 2; ++kb) { for (int i = 0; i < 16; ++i) Sx[kb][i] = 0.f;
            const bf16_t* kp = kc < 8 ? KC + ((size_t)(b * 512 + kc * 64 + kb * 32 + n) * 1024 + h * 64 + 8 * hf) : QK + (size_t)(MPR + b * 16 + qi) * 2048 + 1024 + h * 64 + 8 * hf;
#pragma unroll
            for (int s = 0; s < 4; ++s) Sx[kb] = MFMA32(*(const bf16x8*)(kp + 16 * s), Qf[s], Sx[kb]); }
        s16x4 Vlo[2][2][2], Vhi[2][2][2];
#pragma unroll
        for (int kb = 0; kb < 2; ++kb)
#pragma unroll
            for (int s2 = 0; s2 < 2; ++s2)
#pragma unroll
                for (int db = 0; db < 2; ++db) { const bf16_t* vp = kc < 8 ? VTC + ((size_t)(b * 1024 + h * 64 + db * 32 + n) * 512 + kc * 64 + kb * 32 + 16 * s2 + 4 * hf)
                                                                       : VT + (size_t)(h * 64 + db * 32 + n) * MPAD + MPR + b * 16 + kb * 32 + 16 * s2 + 4 * hf;
                    Vlo[kb][s2][db] = *(const s16x4*)vp; Vhi[kb][s2][db] = *(const s16x4*)(vp + 8); }
        float mx = -1e30f;
#pragma unroll
        for (int kb = 0; kb < 2; ++kb)
#pragma unroll
            for (int i = 0; i < 16; ++i) { const int j = kc * 64 + kb * 32 + crow(i, hf); int rel = 512 + qi - j; rel = rel < -128 ? -128 : (rel > 128 ? 128 : rel);
                float sv = Sx[kb][i] * LOG2E + tbl[rel + 128]; sv = j < 528 ? sv : -1e30f; Sx[kb][i] = sv; mx = fmaxf(mx, sv); }
        mx = fmaxf(mx, __shfl_xor(mx, 32));
        const float mnew = fmaxf(mrun, mx); const float alpha = __builtin_amdgcn_exp2f(mrun - mnew); mrun = mnew;
        float ls = 0.f;
#pragma unroll
        for (int kb = 0; kb < 2; ++kb)
#pragma unroll
            for (int i = 0; i < 16; ++i) { Sx[kb][i] = __builtin_amdgcn_exp2f(Sx[kb][i] - mnew); ls += Sx[kb][i]; }
        lrun = lrun * alpha + ls;
#pragma unroll
        for (int i = 0; i < 16; ++i) { O[0][i] *= alpha; O[1][i] *= alpha; }
#pragma unroll
        for (int kb = 0; kb < 2; ++kb)
#pragma unroll
            for (int s2 = 0; s2 < 2; ++s2) {
                u32x4 pp; pp.x = pk2(Sx[kb][8 * s2], Sx[kb][8 * s2 + 1]); pp.y = pk2(Sx[kb][8 * s2 + 2], Sx[kb][8 * s2 + 3]); pp.z = pk2(Sx[kb][8 * s2 + 4], Sx[kb][8 * s2 + 5]); pp.w = pk2(Sx[kb][8 * s2 + 6], Sx[kb][8 * s2 + 7]);
                const bf16x8 Pf = __builtin_bit_cast(bf16x8, pp);
#pragma unroll
                for (int db = 0; db < 2; ++db) { const bf16x8 Vf = __builtin_shufflevector(Vlo[kb][s2][db], Vhi[kb][s2][db], 0, 1, 2, 3, 4, 5, 6, 7);
                    O[db] = MFMA32(Vf, Pf, O[db]); } }
    }
    const float l = lrun + __shfl_xor(lrun, 32); const float inv = 1.f / l;
    if (n < 16) {
#pragma unroll
        for (int db = 0; db < 2; ++db)
#pragma unroll
            for (int g4 = 0; g4 < 4; ++g4) { const int d0 = db * 32 + 8 * g4 + 4 * hf; u32x2 o; o.x = pk2(O[db][4 * g4] * inv, O[db][4 * g4 + 1] * inv); o.y = pk2(O[db][4 * g4 + 2] * inv, O[db][4 * g4 + 3] * inv);
                *(u32x2*)(MIX + (size_t)mq * 2048 + h * 64 + d0) = o; } }
}

DI void attn_sample_task(const Params& p, LAS unsigned char* lds, int bt, const int tid_o) {
    const int tid = tid_o, wave = tid >> 6, lane = tid & 63;
    unsigned char* ws = p.ws;
    const bf16_t* QK = (const bf16_t*)(ws + WS_QK); const bf16_t* VT = (const bf16_t*)(ws + WS_VT); bf16_t* MIX = (bf16_t*)(ws + WS_MIXIN);
    const int b = bt >> 4, h = bt & 15;
    LAS float* qs = (LAS float*)lds;
    LAS float* sc = qs + 1024;
    LAS float* tbl = sc + 16 * 528;
    LAS float* rinv = tbl + 260;
    __syncthreads();
    for (int i = tid; i < 1024; i += 512) qs[i] = bf1(QK[(size_t)(MPR + b * 16 + (i >> 6)) * 2048 + h * 64 + (i & 63)]);
    for (int i = tid; i < 257; i += 512) tbl[i] = p.in[I_RB][h * 257 + i];
    __syncthreads();
    for (int j = tid; j < 528; j += 512) {
        float kv[64];
        if (j < 512) { const float* kp = p.in[I_CK] + (((size_t)b * 512 + j) * 16 + h) * 64;
#pragma unroll
            for (int d = 0; d < 16; ++d) { const f32x4 v = *(const f32x4*)(kp + 4 * d); kv[4 * d] = v.x; kv[4 * d + 1] = v.y; kv[4 * d + 2] = v.z; kv[4 * d + 3] = v.w; } }
        else { const bf16_t* kp = QK + (size_t)(MPR + b * 16 + (j - 512)) * 2048 + 1024 + h * 64;
#pragma unroll
            for (int d = 0; d < 8; ++d) unpack8(*(const u32x4*)(kp + 8 * d), kv + 8 * d); }
        for (int i = 0; i < 16; ++i) { float s = 0.f;
#pragma unroll
            for (int d = 0; d < 64; ++d) s += qs[i * 64 + d] * kv[d];
            int rel = 512 + i - j; rel = rel < -128 ? -128 : (rel > 128 ? 128 : rel);
            sc[i * 528 + j] = s + tbl[rel + 128]; }
    }
    __syncthreads();
    for (int i = wave * 2; i < wave * 2 + 2; ++i) { float mx = -1e30f;
        for (int j = lane; j < 528; j += 64) mx = fmaxf(mx, sc[i * 528 + j]);
#pragma unroll
        for (int o = 1; o < 64; o <<= 1) mx = fmaxf(mx, __shfl_xor(mx, o));
        float sum = 0.f;
        for (int j = lane; j < 528; j += 64) { const float e = __expf(sc[i * 528 + j] - mx); sc[i * 528 + j] = e; sum += e; }
        sum = wave_sum(sum);
        if (lane == 0) rinv[i] = 1.f / sum; }
    __syncthreads();
    {
        LAS float* red = rinv + 16;
        const int d = tid & 63, kg = tid >> 6; float acc[16];
#pragma unroll
        for (int i = 0; i < 16; ++i) acc[i] = 0.f;
        const float* vp = p.in[I_CV] + ((size_t)b * 512 * 16 + h) * 64 + d;
        const bf16_t* vt = VT + (size_t)(h * 64 + d) * MPAD + MPR + b * 16;
#pragma unroll 1
        for (int j0 = kg * 66; j0 < kg * 66 + 66; j0 += 11) { float v[11];
#pragma unroll
            for (int u = 0; u < 11; ++u) { const int j = j0 + u; const int jc = j < 512 ? j : 511; const float vc = vp[(size_t)jc * 1024]; const float vn = bf1(vt[j < 512 ? 0 : j - 512]); v[u] = j < 512 ? vc : vn; }
#pragma unroll
            for (int u = 0; u < 11; ++u)
#pragma unroll
                for (int i = 0; i < 16; ++i) acc[i] += sc[i * 528 + j0 + u] * v[u]; }
#pragma unroll
        for (int i = 0; i < 16; ++i) red[(kg * 16 + i) * 64 + d] = acc[i];
        __syncthreads();
        for (int o = tid; o < 1024; o += 512) { const int i = o >> 6, dd = o & 63; float sum = 0.f;
#pragma unroll
            for (int g = 0; g < 8; ++g) sum += red[(g * 16 + i) * 64 + dd];
            MIX[(size_t)(MPR + b * 16 + i) * 2048 + h * 64 + dd] = (bf16_t)(pk2(sum * rinv[i], 0.f) & 0xffffu); }
    }
}

DI void phase_mix(const Params& p, LAS unsigned char* lds, const int tid_o) {
    const int blk = blockIdx.x, G = gridDim.x;
    const int wave = __builtin_amdgcn_readfirstlane(tid_o >> 6), lane = tid_o & 63;
    __syncthreads();
    if (tid_o < 2 * SC_NB + 4) ((LAS unsigned*)(lds + L_FLAGS))[tid_o] = 0u;
    __syncthreads();
    if (wave <= 3) __builtin_amdgcn_s_setprio(3);
    if (wave <= 5) { scan_run(p, lds, wave, lane, blk, G);
        LAS unsigned* sdone = (LAS unsigned*)(lds + L_FLAGS) + 8;
        asm volatile("" ::: "memory");
        if (lane == 0) __hip_atomic_fetch_add(sdone, 1u, __ATOMIC_RELAXED, __HIP_MEMORY_SCOPE_WORKGROUP);
        if (wave <= 3) { while (__hip_atomic_load(sdone, __ATOMIC_RELAXED, __HIP_MEMORY_SCOPE_WORKGROUP) < 6u) __builtin_amdgcn_s_sleep(1); asm volatile("" ::: "memory"); } }
#if REPEAT_SUB == 1
    __syncthreads();
    if (tid_o < 2 * SC_NB) ((LAS unsigned*)(lds + L_FLAGS))[tid_o] = 0u;
    __syncthreads();
    if (wave <= 5) scan_run(p, lds, wave, lane, blk, G);
#endif
    __builtin_amdgcn_s_setprio(0);
    if (wave <= 3 || wave >= 6) {
        LAS float* tbl = (LAS float*)(lds + L_TBL + wave * 1040);
        LAS unsigned char* kv = wave >= 6 ? lds + L_KV + (wave - 6) * KV_BYTES : lds + wave * KV_BYTES;
        const unsigned myq = (unsigned)__builtin_amdgcn_s_getreg((3 << 11) | 20) & 7u;
        for (unsigned qo = 0; qo < 8u; ++qo) { const unsigned q = (myq + qo) & 7u; unsigned* ctr = (unsigned*)(p.ws + WS_CTR) + 128 + 16 * q;
            for (;;) { unsigned t = 0; if (lane == 0) t = atomicAdd(ctr, 1u); t = __builtin_amdgcn_readfirstlane(t); if (t >= 528u) break;
                if (t < 16u) attn_sample_wave(p, tbl, (int)(q + 8u * t), lane);
                else { const unsigned tp = t - 16u, rem = tp & 15u, bhp = q + 8u * (rem >> 1); const int task = (int)((tp >> 4) * 128u + (bhp >> 4) * 32u + (bhp & 15u) * 2u + (rem & 1u));
                    attn_wave_task(p, tbl, kv, task, lane); } } }
    }
}

DI void phase_post(const Params& p, const int tid_o) {
    const int tid = tid_o, wave = tid >> 6, lane = tid & 63, blk = blockIdx.x, G = gridDim.x;
    unsigned char* ws = p.ws;
    const float* Y = (const float*)(ws + WS_Y); const bf16_t* FV = (const bf16_t*)(ws + WS_FV); const bf16_t* GG = (const bf16_t*)(ws + WS_GG); const float* BON = (const float*)(ws + WS_BONUS);
    bf16_t* MIX = (bf16_t*)(ws + WS_MIXIN);
    const int gw = blk * 8 + wave, NGW = G * 8;
    for (int i = blk * 512 + tid; i < MS * DM / 4; i += G * 512) *(f32x4*)(p.out + (size_t)MPR * DM + (size_t)i * 4) = *(const f32x4*)(p.in[I_XS] + (size_t)i * 4);
    { float* out = p.out; const bf16_t* VT = (const bf16_t*)(ws + WS_VT);
    for (int task = gw; task < 16 * 34; task += NGW) { const int cb = task & 15, mc = task >> 4; const int c = cb * 64 + lane;
        const int mbase = mc < 32 ? ((mc >> 3) * SEQ + (SEQ - 512) + (mc & 7) * 64) : MPR + (mc - 32) * 64;
        float* ob = mc < 32 ? out + O_VP + ((size_t)(mc >> 3) * 512 + (mc & 7) * 64) * 1024 + c : out + O_VS + (size_t)((mc - 32) * 64) * 1024 + c;
        u32x4 raw[8];
#pragma unroll
        for (int j = 0; j < 8; ++j) raw[j] = *(const u32x4*)(VT + (size_t)c * MPAD + mbase + 8 * j);
#pragma unroll
        for (int j = 0; j < 8; ++j) { float f[8]; unpack8(raw[j], f);
#pragma unroll
            for (int e = 0; e < 8; ++e) ob[(size_t)(8 * j + e) * 1024] = f[e]; __builtin_amdgcn_sched_barrier(0); } }
    }
    for (int m = gw; m < MT; m += NGW) {
#pragma unroll
        for (int it = 0; it < 2; ++it) { const int c = it * 512 + lane * 8, h = c >> 6;
            const f32x4 y0 = __builtin_nontemporal_load((const f32x4*)(Y + (size_t)m * 1024 + c)), y1 = __builtin_nontemporal_load((const f32x4*)(Y + (size_t)m * 1024 + c + 4));
            float y[8] = {y0.x, y0.y, y0.z, y0.w, y1.x, y1.y, y1.z, y1.w};
            float s = 0.f;
#pragma unroll
            for (int j = 0; j < 8; ++j) s += y[j];
            s += __shfl_xor(s, 1); s += __shfl_xor(s, 2); s += __shfl_xor(s, 4);
            const float mu = s * (1.f / 64.f); float v2 = 0.f;
#pragma unroll
            for (int j = 0; j < 8; ++j) { y[j] -= mu; v2 += y[j] * y[j]; }
            v2 += __shfl_xor(v2, 1); v2 += __shfl_xor(v2, 2); v2 += __shfl_xor(v2, 4);
            const float rstd = rsqrtf(v2 * (1.f / 64.f) + 64e-5f);
            float vv[8], gg[8]; unpack8(__builtin_nontemporal_load((const u32x4*)(FV + (size_t)m * 1024 + c)), vv); unpack8(__builtin_nontemporal_load((const u32x4*)(GG + (size_t)m * 1024 + c)), gg);
            const float bon = BON[(size_t)m * 16 + h];
            const float* lw = p.in[I_LW] + c; const float* lb = p.in[I_LB] + c;
            float o[8];
#pragma unroll
            for (int j = 0; j < 8; ++j) { const float yn = y[j] * rstd * lw[j] + lb[j]; o[j] = (yn + bon * vv[j]) * gg[j]; }
            u32x4 q; q.x = pk2(o[0], o[1]); q.y = pk2(o[2], o[3]); q.z = pk2(o[4], o[5]); q.w = pk2(o[6], o[7]);
            *(u32x4*)(MIX + (size_t)m * 2048 + 1024 + c) = q; }
    }
}

DI void phase_act(const Params& p, const int tid_o) {
    const int tid = tid_o, blk = blockIdx.x, G = gridDim.x;
    unsigned char* ws = p.ws; float* out = p.out;
    bf16_t* GV = (bf16_t*)(ws + WS_GV);
    const float* cst = p.in[I_SC];
    for (int it = blk * 512 + tid; it < 130 * 704; it += G * 512) {
        const int f = (it % 704) * 8, strip = it / 704, m0 = strip * 64;
        float w0[8], w1[8], w2[8], bb[8];
#pragma unroll
        for (int j = 0; j < 8; ++j) { w0[j] = p.in[I_DWC][f + j]; w1[j] = p.in[I_DWC][DFF + f + j]; w2[j] = p.in[I_DWC][2 * DFF + f + j]; bb[j] = p.in[I_DWB][f + j]; }
        float p1[8], p2[8];
        for (int r0 = 0; r0 < 64; r0 += 4) {
            u32x4 craw[4], vraw[4];
#pragma unroll
            for (int rr = 0; rr < 4; ++rr) { craw[rr] = __builtin_nontemporal_load((const u32x4*)(GV + (size_t)(m0 + r0 + rr) * (2 * DFF) + f)); vraw[rr] = __builtin_nontemporal_load((const u32x4*)(GV + (size_t)(m0 + r0 + rr) * (2 * DFF) + DFF + f)); }
#pragma unroll
            for (int rr = 0; rr < 4; ++rr) { const int r = r0 + rr, m = m0 + r;
                int t, b; const bool samp = m >= MPR; if (samp) { t = (m - MPR) & 15; b = (m - MPR) >> 4; } else { t = m & (SEQ - 1); b = m >> 11; }
                if (r == 0 || t == 0) {
#pragma unroll
                    for (int off = 1; off <= 2; ++off) { float* d = off == 1 ? p1 : p2;
                        if (t - off >= 0) unpack8(*(const u32x4*)(GV + (size_t)(m - off) * (2 * DFF) + f), d);
                        else if (samp) { const float* sp = cst + ((size_t)b * 2 + (2 + t - off)) * DFF + f;
#pragma unroll
                            for (int j = 0; j < 8; ++j) d[j] = sp[j]; }
                        else {
#pragma unroll
                            for (int j = 0; j < 8; ++j) d[j] = 0.f; } } }
                float cur[8], val[8]; unpack8(craw[rr], cur); unpack8(vraw[rr], val);
                float o[8];
#pragma unroll
                for (int j = 0; j < 8; ++j) { const float cv = bb[j] + w0[j] * p2[j] + w1[j] * p1[j] + w2[j] * cur[j]; o[j] = gelu_f(cv) * val[j]; }
                u32x4 q; q.x = pk2(o[0], o[1]); q.y = pk2(o[2], o[3]); q.z = pk2(o[4], o[5]); q.w = pk2(o[6], o[7]);
                *(u32x4*)(GV + (size_t)m * (2 * DFF) + DFF + f) = q;
                const int tl = samp ? 14 : SEQ - 2;
                if (t >= tl) { float* op = out + (samp ? O_CVS : O_CVP) + ((size_t)b * 2 + (t - tl)) * DFF + f;
                    *(f32x4*)op = (f32x4){cur[0], cur[1], cur[2], cur[3]}; *(f32x4*)(op + 4) = (f32x4){cur[4], cur[5], cur[6], cur[7]}; }
#pragma unroll
                for (int j = 0; j < 8; ++j) { p2[j] = p1[j]; p1[j] = cur[j]; }
            }
        }
    }
}

#define XB_TMO      128
#define XB_XCNT(j)  (256  + 64 * (j))
#define XB_XSUB(j)  (1280 + 64 * (j))
#define XB_XGEN(j)  (2304 + 64 * (j))
#define XB_TOP      3328
#define XB_TOPGEN   3392
#define XCD_BAR_WORDS 3456
#define XB_SPIN_CAP (1u << 20)
DI unsigned xb_ld(unsigned* p)              { return __hip_atomic_load(p, __ATOMIC_RELAXED, __HIP_MEMORY_SCOPE_AGENT); }
DI unsigned xb_add(unsigned* p, unsigned v) { return __hip_atomic_fetch_add(p, v, __ATOMIC_RELAXED, __HIP_MEMORY_SCOPE_AGENT); }
DI unsigned xb_xcc_id() { return (unsigned)__builtin_amdgcn_s_getreg((3 << 11) | 20) & 0xFu; }
#define XB_SPIN(cond, bar) do { unsigned _sp = 0; while (cond) { __builtin_amdgcn_s_sleep(1); \
    if ((++_sp & 255u) == 0u) { if (xb_ld(&(bar)[XB_TMO])) break; if (_sp > XB_SPIN_CAP) { atomicAdd(&(bar)[XB_TMO], 1u); break; } } } } while (0)
DI void xcd_barrier_complete(unsigned* bar, unsigned x, unsigned& nloc, unsigned& nx) {
    const unsigned G = gridDim.x;
    unsigned sum, cnt, mine, sp = 0u;
    for (;;) {
        sum = 0u; cnt = 0u; mine = 0u;
#pragma unroll
        for (unsigned j = 0; j < 16; ++j) { const unsigned c = xb_ld(&bar[XB_XCNT(j)]); sum += c; cnt += (c > 0u) ? 1u : 0u; mine = (j == x) ? c : mine; }
        if (sum == G) break;
        __builtin_amdgcn_s_sleep(1);
        if ((++sp & 255u) == 0u) { if (xb_ld(&bar[XB_TMO])) break; if (sp > XB_SPIN_CAP) { atomicAdd(&bar[XB_TMO], 1u); break; } }
    }
    nloc = mine > 0u ? mine : 1u; nx = cnt > 0u ? cnt : 1u;
}
DI void xcd_barrier(unsigned* bar, const unsigned x, volatile LAS unsigned* st, const int tid_o) {
    asm volatile("s_waitcnt vmcnt(0)" ::: "memory");
    __syncthreads();
    if (tid_o == 0) {
        __builtin_amdgcn_s_waitcnt(0);
        unsigned nloc = st[0], nx = st[1];
        if (nloc == 0u) { xcd_barrier_complete(bar, x, nloc, nx); st[0] = nloc; st[1] = nx; }
        const unsigned old = xb_add(&bar[XB_XSUB(x)], 1u);
        const unsigned gen = old / nloc;
        if (old + 1u == (gen + 1u) * nloc) {
            __builtin_amdgcn_fence(__ATOMIC_RELEASE, "agent");
            asm volatile("s_waitcnt vmcnt(0)" ::: "memory");
            const unsigned og = xb_add(&bar[XB_TOP], 1u);
            const unsigned tg = og / nx;
            if (og + 1u == (tg + 1u) * nx) xb_add(&bar[XB_TOPGEN], 1u);
            else XB_SPIN(xb_ld(&bar[XB_TOPGEN]) == tg, bar);
            __builtin_amdgcn_fence(__ATOMIC_ACQUIRE, "agent");
            xb_add(&bar[XB_XGEN(x)], 1u);
            asm volatile("s_waitcnt vmcnt(0)" ::: "memory");
        } else {
            XB_SPIN(xb_ld(&bar[XB_XGEN(x)]) == gen, bar);
            __builtin_amdgcn_fence(__ATOMIC_ACQUIRE, "agent");
            asm volatile("s_waitcnt vmcnt(0)" ::: "memory");
        }
    }
    __syncthreads();
}

constexpr int NPHASE = 10;
__global__ void __launch_bounds__(512, 2) mega(Params p) {
    extern __shared__ __attribute__((aligned(16))) unsigned char shm[];
    LAS unsigned char* lds = (LAS unsigned char*)shm;
    cg::grid_group grid = cg::this_grid();
    unsigned char* ws = p.ws;
    const int G = gridDim.x, c = blockIdx.x;
#if PROG == 1
    constexpr int PROGRAM[] = {0, 1, 2, 3, 2, 3, 4, 5, 6, 7, 8, 9, 10};
#elif PROG == 2
    constexpr int PROGRAM[] = {0, 1, 2, 3, 4, 5, 6, 7, 8, 9, 8, 9, 10};
#elif PROG == 3
    constexpr int PROGRAM[] = {0, 1, 2, 3, 4, 5, 6, 7, 8, 9, 10, 5, 6, 10};
#elif PROG == 4
    constexpr int PROGRAM[] = {0, 1, 2, 3, 4, 5, 6, 5, 6, 7, 8, 9, 10};
#elif PROG == 5
    constexpr int PROGRAM[] = {0, 1, 2, 3, 4, 2, 3, 4, 5, 6, 7, 8, 9, 10};
#elif PROG == 7
    constexpr int PROGRAM[] = {0, 1, 2, 3, 4, 5, 6, 7, 8, 9, 11, 10};
#elif PROG == 8
    constexpr int PROGRAM[] = {0, 12, 12, 12, 12, 12, 12, 12, 12, 12, 12, 1, 2, 3, 4, 5, 6, 7, 8, 9, 10};
#elif PROG == 6
    constexpr int PROGRAM[] = {0, 0, 1, 1, 2, 3, 4, 5, 6, 7, 7, 8, 9, 10};
#else
    constexpr int PROGRAM[] = {0, 1, 2, 3, 4, 5, 6, 7, 8, 9, 10, 13};
#endif
    constexpr int NPROG = sizeof(PROGRAM) / sizeof(int);
    unsigned* xbar = (unsigned*)(ws + WS_BAR); const unsigned xcc = xb_xcc_id(); volatile LAS unsigned* xst = (volatile LAS unsigned*)(lds + 132864);
    if (threadIdx.x < 4) xst[threadIdx.x] = 0u;
    if (threadIdx.x == 0) (void)xb_add(&xbar[XB_XCNT(xcc)], 1u);
    __syncthreads();
    for (int pi = p.ph_lo; pi < p.ph_hi; ++pi) {
        int ph = 0;
#pragma unroll
        for (int q = 0; q < NPROG; ++q) if (q == pi) ph = PROGRAM[q];
        int tid_o = threadIdx.x; asm volatile("" : "+v"(tid_o));
        switch (ph) {
#ifndef ONLY
#define ONLY -1
#endif
#define PHON(x) (ONLY < 0 || ONLY == (x))
        case 0: if (PHON(0)) phase0(p, lds, tid_o); break;
        case 1: if (PHON(1)) phase_norm<0>(p, lds, tid_o); break;
        case 2: if (PHON(2)) { SchedIn S; S.H = (const char*)(ws + WS_H); S.W = (const char*)(ws + WS_WT_IN); S.G = G; S.c = c; S.base = 0; S.limit = G == 256 ? 768 : 825;
                  EpiIn E; E.QK = (bf16_t*)(ws + WS_QK); E.VT = (bf16_t*)(ws + WS_VT); E.ZR = (bf16_t*)(ws + WS_ZR);
                  pg8::gemm_phase(lds, pg8::GemmK{DM, DM, DM}, S, E, tid_o);
                  } break;
        case 3: if (PHON(3)) phase_prep(p, lds, tid_o); break;
        case 4: if (PHON(4)) phase_mix(p, lds, tid_o);
#if REPEAT_SUB == 4
            grid.sync(); if (blockIdx.x == 0 && tid_o < 64) ((unsigned*)(ws + WS_CTR))[tid_o] = 0u; grid.sync(); phase_mix(p, lds, tid_o);
#endif
            break;
        case 5: if (PHON(5)) phase_post(p, tid_o); break;
        case 6: if (PHON(6)) { SchedPlain S; S.A = (const char*)(ws + WS_MIXIN); S.B = (const char*)(ws + WS_WT_OUT); S.G = G; S.c = c; S.nM = 32; S.nN = 8; S.nfull = 256; S.ntK = DM / 64; S.total = 256 + 8 * 8; S.astep = (size_t)256 * DM * 2; S.bstep = (size_t)256 * DM * 2;
                  EpiRes<false> E; E.out = p.out; E.xp = p.in[I_XP]; E.xs = p.in[I_XS]; E.MOD = (const float*)(ws + WS_MOD); E.goff = 2 * DM; E.slab = (float*)(ws + WS_FV);
                  pg8::gemm_phase(lds, pg8::GemmK{DM, DM, DM}, S, E, tid_o); } break;
        case 7: if (PHON(7)) phase_norm<1>(p, lds, tid_o); break;
        case 8: if (PHON(8)) { SchedPlain S; S.A = (const char*)(ws + WS_H); S.B = (const char*)(ws + WS_WT_UP); S.G = G; S.c = c; S.nM = 33; S.nN = 44; S.nfull = 33 * 44; S.ntK = DM / 64; S.total = 33 * 44; S.astep = (size_t)256 * DM * 2; S.bstep = (size_t)256 * DM * 2;
                  EpiUp E; E.GV = (bf16_t*)(ws + WS_GV);
                  pg8::gemm_phase(lds, pg8::GemmK{DM, DM, DM}, S, E, tid_o); } break;
        case 9: if (PHON(9)) phase_act(p, tid_o); break;
#if PROG == 7
        case 11: { SchedPlain S; S.A = (const char*)(ws + WS_GV) + (size_t)DFF * 2; S.B = (const char*)(ws + WS_WT_DOWN); S.G = G; S.c = c; S.nM = 32; S.nN = 8; S.nfull = 256; S.ntK = DFF / 64; S.total = 256 + 8 * 22; S.astep = (size_t)256 * (2 * DFF) * 2; S.bstep = (size_t)256 * DFF * 2;
                  EpiNull E; E.sink = (float*)(ws + WS_CTR + 1024);
                  pg8::gemm_phase(lds, pg8::GemmK{DFF, 2 * DFF, DFF}, S, E, tid_o); } break;
#endif
        case 13: {
            const float* slab = (const float*)(ws + WS_FV); const float* MOD = (const float*)(ws + WS_MOD);
            for (int i = blockIdx.x * 512 + tid_o; i < MS * DM / 4; i += G * 512) { const int r = i >> 9, c4 = (i & 511) * 4; f32x4 sum = (f32x4){0.f, 0.f, 0.f, 0.f};
#pragma unroll
                for (int ks = 0; ks < 22; ++ks) sum += *(const f32x4*)(slab + ((size_t)ks * MS + r) * DM + c4);
                const f32x4 g = *(const f32x4*)(MOD + (size_t)(4 + (r >> 4)) * NMOD + 5 * DM + c4); f32x4* op = (f32x4*)(p.out + (size_t)(MPR + r) * DM + c4); *op = *op + g * sum; }
            } break;
        case 10: if (PHON(10)) { SchedPlain S; S.A = (const char*)(ws + WS_GV) + (size_t)DFF * 2; S.B = (const char*)(ws + WS_WT_DOWN); S.G = G; S.c = c; S.nM = 32; S.nN = 8; S.nfull = 256; S.ntK = DFF / 64; S.total = 256 + 8 * 22; S.astep = (size_t)256 * (2 * DFF) * 2; S.bstep = (size_t)256 * DFF * 2;
                  EpiRes<true> E; E.out = p.out; E.xp = nullptr; E.xs = nullptr; E.MOD = (const float*)(ws + WS_MOD); E.goff = 5 * DM; E.slab = (float*)(ws + WS_FV);
                  pg8::gemm_phase(lds, pg8::GemmK{DFF, 2 * DFF, DFF}, S, E, tid_o); } break;
        }
        if (pi + 1 < p.ph_hi) { if (p.ph_hi < 0) grid.sync(); xcd_barrier(xbar, xcc, xst, tid_o); }
    }
}

extern "C" void kernel_launch(void* const* d_in, const int* in_sizes, int n_in, void* d_out, int out_size, void* d_ws, size_t ws_size, hipStream_t stream) {
    constexpr size_t kDynLds = 133120;
    static int grid_blocks = 0;
    if (!grid_blocks) {
        int dev = 0, cus = 0, per_cu = 0;
        hipGetDevice(&dev);
        hipDeviceGetAttribute(&cus, hipDeviceAttributeMultiprocessorCount, dev);
        hipFuncSetAttribute((const void*)mega, hipFuncAttributeMaxDynamicSharedMemorySize, (int)kDynLds);
        hipOccupancyMaxActiveBlocksPerMultiprocessor(&per_cu, (const void*)mega, 512, kDynLds);
        if (per_cu < 1) per_cu = 1;
        grid_blocks = cus * per_cu;
        if (grid_blocks > 256) grid_blocks = 256;
    }
    Params p{};
    for (int i = 0; i < 33; ++i) p.in[i] = (const float*)d_in[i];
    p.out = (float*)d_out; p.ws = (unsigned char*)d_ws;
#if N_LAUNCH_PER_PHASE
    for (int ph = 0; ph < 11; ++ph) { p.ph_lo = ph; p.ph_hi = ph + 1; hipLaunchKernelGGL(mega, dim3(grid_blocks), dim3(512), kDynLds, stream, p); }
#else
    hipMemsetAsync((unsigned char*)d_ws + WS_BAR, 0, 16384, stream);
    p.ph_lo = 0; p.ph_hi = (PROG == 0) ? 12 : (PROG == 8 ? 21 : PROG == 7 ? 12 : ((PROG == 3 || PROG == 5 || PROG == 6) ? 14 : 13));
    void* args[] = {&p};
    hipError_t e = hipLaunchCooperativeKernel((const void*)mega, dim3(grid_blocks), dim3(512), args, kDynLds, stream);
    if (e != hipSuccess) fprintf(stderr, "cooperative launch failed: %s (grid %d)\n", hipGetErrorString(e), grid_blocks);
#endif
}
```

```cpp
#include <hip/hip_runtime.h>
#include <hip/hip_cooperative_groups.h>
#include <cstdio>
namespace cg = cooperative_groups;

#ifndef PROG
#define PROG 0
#endif
#ifndef REPEAT_SUB
#define REPEAT_SUB 0
#endif
#ifndef REPEAT_PHASE
#define REPEAT_PHASE -1
#endif
#ifndef N_LAUNCH_PER_PHASE
#define N_LAUNCH_PER_PHASE 0
#endif

#define DI __device__ __forceinline__
#define LAS __attribute__((address_space(3)))
typedef unsigned short bf16_t;
typedef short bf16x8 __attribute__((ext_vector_type(8)));
typedef short s16x4 __attribute__((ext_vector_type(4)));
typedef float f32x2 __attribute__((ext_vector_type(2)));
typedef float f32x4 __attribute__((ext_vector_type(4)));
typedef float f32x16 __attribute__((ext_vector_type(16)));
typedef unsigned u32x2 __attribute__((ext_vector_type(2)));
typedef unsigned u32x4 __attribute__((ext_vector_type(4)));
typedef __bf16 bf16x2_t __attribute__((ext_vector_type(2)));

constexpr int DM = 2048, SEQ = 2048, MPR = 8192, MS = 128, MT = 8320, MPAD = 8448;
constexpr int DIN = 6400, DSH = 3328, DFF = 5632, NMOD = 12288;
constexpr float LOG2E = 1.4426950408889634f;
enum { I_XP = 0, I_XS, I_CP, I_CS, I_CK, I_CV, I_SR, I_SS, I_SC, I_NAG, I_NFG, I_WADA, I_BADA, I_WIN, I_QG, I_KG, I_RB, I_MU, I_W0, I_W2, I_A0, I_A2, I_G2,
       I_KK, I_KA, I_RK, I_LW, I_LB, I_WOUT, I_WUP, I_DWC, I_DWB, I_WDN };
constexpr size_t O_Y = 0, O_KP = 17039360, O_VP = 19136512, O_SP = 21233664, O_SHP = 21495808, O_CVP = 21509120, O_KS = 21554176, O_VS = 21685248,
                 O_SS = 21816320, O_SHS = 22340608, O_CVS = 22367232;
constexpr size_t WS_WT_OUT = 0, WS_WT_UP = 8388608, WS_WT_DOWN = 54525952, WS_LT = 77594624, WS_MODP = 78118912, WS_MOD = 82837504, WS_BONUS = 83427328,
                 WS_CTR = 83959808, WS_BAR = 83963904, WS_R = 83963904 + 16384;
constexpr size_t WS_WT_IN = WS_R, WS_H = WS_R + 26214400, WS_MIXIN = WS_R, WS_GG = WS_R + 305004544  , WS_QK = WS_R + 60817408, WS_VT = WS_R + 95420416,
                 WS_ZR = WS_R + 112721920, WS_Y = WS_ZR, WS_FW = WS_R + 168951808, WS_FB = WS_R + 203030528, WS_FV = WS_R + 271187968, WS_GV = WS_QK, WS_KC = WS_R + 288227328, WS_VTC = WS_R + 288227328 + 8388608;

struct Params { const float* in[33]; float* out; unsigned char* ws; int ph_lo, ph_hi; };

DI unsigned pk2(float a, float b) { f32x2 v = {a, b}; bf16x2_t r = __builtin_convertvector(v, bf16x2_t); return __builtin_bit_cast(unsigned, r); }
DI float bflo(unsigned u) { return __uint_as_float(u << 16); }
DI float bfhi(unsigned u) { return __uint_as_float(u & 0xffff0000u); }
DI float bf1(bf16_t u) { return __uint_as_float(((unsigned)u) << 16); }
DI void unpack8(u32x4 v, float* f) { f[0] = bflo(v.x); f[1] = bfhi(v.x); f[2] = bflo(v.y); f[3] = bfhi(v.y); f[4] = bflo(v.z); f[5] = bfhi(v.z); f[6] = bflo(v.w); f[7] = bfhi(v.w); }
DI void unpack4(u32x2 v, float* f) { f[0] = bflo(v.x); f[1] = bfhi(v.x); f[2] = bflo(v.y); f[3] = bfhi(v.y); }
DI float wave_sum(float v) {
#pragma unroll
    for (int o = 1; o < 64; o <<= 1) v += __shfl_xor(v, o);
    return v;
}
DI float dpp_ror_add(float s, int) { return s; }
#define DPP_ADD(s, ctrl) ((s) + __builtin_bit_cast(float, __builtin_amdgcn_update_dpp(0, __builtin_bit_cast(int, (s)), (ctrl), 0xf, 0xf, false)))
DI float row16_sum(float s) { s = DPP_ADD(s, 0x128); s = DPP_ADD(s, 0x124); s = DPP_ADD(s, 0x122); s = DPP_ADD(s, 0x121); return s; }
DI int crow(int reg, int h) { return (reg & 3) + 8 * (reg >> 2) + 4 * h; }
DI float sigmoidf_(float x) { return 1.f / (1.f + __expf(-x)); }
#define MFMA32(a, b, c) __builtin_amdgcn_mfma_f32_32x32x16_bf16((a), (b), (c), 0, 0, 0)

DI float gelu_f(float v) {
    const float av = fabsf(v), d = av * 0.2316418882f + 1.0f;
    const float t = __builtin_amdgcn_rcpf(d);
    float q = t * 0.5307027145f + (-0.7265760135f); q = q * t + 0.7107068705f; q = q * t + (-0.142248368f); q = q * t + 0.127414796f; q = q * t;
    const float e = __builtin_amdgcn_exp2f((v * v) * (-0.72134752044f));
    const float m = v * (q * e), r = v - m;
    return v < 0.f ? m : r;
}

namespace pg8 {
constexpr int BM = 256, BK = 64, HALF = 128, HTB = HALF * BK * 2, STAGE_BYTES = 8 * HTB;
DI int lds_byte(int r, int c) { const int st = (r >> 4) * 2 + (c >> 5), rr = r & 15, cc = c & 31, ob = rr * 64 + cc * 2; return st * 1024 + (ob ^ (((ob >> 9) & 1) << 5)); }
DI void stage_rc(int b, int& R, int& C) { const int st = b / 1024, sb = b % 1024, swz = sb ^ (((sb >> 9) & 1) << 5); R = (st >> 1) * 16 + swz / 64; C = (st & 1) * 32 + (swz % 64) / 2; }
DI int perm32(int rho) { const int n = rho >> 4, i = rho & 15; return 8 * (i >> 2) + 4 * n + (i & 3); }
struct Unit { const char* a; const char* b; int kind, pm, pn, nt, ks; };
struct GemmK { int K, lda, ldb; };

template <class Epi, class Sched>
DI void gemm_phase(LAS unsigned char* lds, const GemmK g, const Sched& S, const Epi& E, const int tid_o) {
    const int tid = tid_o, wid = __builtin_amdgcn_readfirstlane(tid >> 6), lane = tid & 63, wr = wid >> 2, wc = wid & 3, fr = lane & 15, fq = lane >> 4;
    unsigned voffA[2], voffB[2];
#pragma unroll
    for (int i = 0; i < 2; ++i) { int R, C; stage_rc(tid * 16 + i * 8192, R, C); const int Rb = Epi::PERM ? ((R & ~31) + perm32(R & 31)) : R;
        voffA[i] = (unsigned)(R * g.lda + C) * 2u; voffB[i] = (unsigned)(Rb * g.ldb + C) * 2u; }
    const size_t kstep = (size_t)(BK * 2);
    const size_t hstepA = (size_t)HALF * g.lda * 2, hstepB = (size_t)HALF * g.ldb * 2;
    const unsigned ldsw = (unsigned)wid * 1024u;
    const int aoff = lds_byte(wr * 64 + fr, fq * 8), boff = lds_byte(wc * 32 + fr, fq * 8);
#define PG8_SA(b, h) (((b) * 2 + (h)) * HTB)
#define PG8_SB(b, h) ((4 + (b) * 2 + (h)) * HTB)
#define PG8_STAGE(bufoff, gbase, voff) do { _Pragma("unroll") for (int _i = 0; _i < 2; ++_i) \
        __builtin_amdgcn_global_load_lds((const unsigned*)((const char*)(gbase) + (voff)[_i]), (LAS unsigned*)(lds + (bufoff) + ldsw + _i * 8192), 16, 0, 0); } while (0)
#define PG8_LDA(dst, b, h) do { _Pragma("unroll") for (int m = 0; m < 4; ++m) _Pragma("unroll") for (int k = 0; k < 2; ++k) dst[m][k] = *(const LAS bf16x8*)(lds + PG8_SA(b, h) + aoff + m * 2048 + k * 1024); } while (0)
#define PG8_LDB(dst, b, h) do { _Pragma("unroll") for (int n = 0; n < 2; ++n) _Pragma("unroll") for (int k = 0; k < 2; ++k) dst[n][k] = *(const LAS bf16x8*)(lds + PG8_SB(b, h) + boff + n * 2048 + k * 1024); } while (0)
#define PG8_MMA(ai, bj, At, Bt) do { __builtin_amdgcn_s_setprio(1); _Pragma("unroll") for (int m = 0; m < 4; ++m) _Pragma("unroll") for (int n = 0; n < 2; ++n) _Pragma("unroll") for (int k = 0; k < 2; ++k) \
        acc[ai][bj][m][n] = __builtin_amdgcn_mfma_f32_16x16x32_bf16(Bt[n][k], At[m][k], acc[ai][bj][m][n], 0, 0, 0); __builtin_amdgcn_s_setprio(0); } while (0)
#define PG8_WAIT_V(n) asm volatile("s_waitcnt vmcnt(" #n ")" ::: "memory")
#define PG8_WAIT_L(n) asm volatile("s_waitcnt lgkmcnt(" #n ")" ::: "memory")
#define PG8_BAR __builtin_amdgcn_s_barrier()
#define PG8_SCHED __builtin_amdgcn_sched_barrier(0)
    Unit cur, nxt; int ui = 0;
    if (!S.next(0, cur)) return;
    f32x4 acc[2][2][4][2];
#pragma unroll
    for (int a = 0; a < 2; ++a)
#pragma unroll
        for (int b = 0; b < 2; ++b)
#pragma unroll
            for (int m = 0; m < 4; ++m)
#pragma unroll
                for (int n = 0; n < 2; ++n) acc[a][b][m][n] = (f32x4){0.f, 0.f, 0.f, 0.f};
    bf16x8 At[4][2], B0[2][2], B1[2][2];
    const char* cA = cur.a; const char* cB = cur.b;
    PG8_STAGE(PG8_SB(0, 0), cB, voffB); PG8_STAGE(PG8_SA(0, 0), cA, voffA); PG8_STAGE(PG8_SB(0, 1), cB + hstepB, voffB); PG8_STAGE(PG8_SA(0, 1), cA + hstepA, voffA);
    if (wr == 1) PG8_BAR;
    PG8_WAIT_V(4); PG8_BAR;
    PG8_STAGE(PG8_SB(1, 0), cB + kstep, voffB); PG8_STAGE(PG8_SA(1, 0), cA + kstep, voffA); PG8_STAGE(PG8_SB(1, 1), cB + hstepB + kstep, voffB);
    PG8_WAIT_V(6); PG8_BAR;
    for (;;) {
        const bool has_next = S.next(ui + 1, nxt);
        const char* nA = has_next ? nxt.a : cA; const char* nB = has_next ? nxt.b : cB;
        const int nt = cur.nt;
        for (int t = 0; t < nt; t += 2) {
            const bool last = (t == nt - 2);
            const char* a1 = cA + (size_t)(t + 1) * kstep;
            const char* a2 = last ? nA : cA + (size_t)(t + 2) * kstep; const char* b2 = last ? nB : cB + (size_t)(t + 2) * kstep;
            const char* a3 = a2 + kstep; const char* b3 = b2 + kstep;
            PG8_LDB(B0, 0, 0); PG8_SCHED; PG8_LDA(At, 0, 0); PG8_STAGE(PG8_SA(1, 1), a1 + hstepA, voffA);
            PG8_WAIT_L(8); PG8_BAR; PG8_WAIT_L(0); PG8_MMA(0, 0, At, B0); PG8_BAR; PG8_SCHED;
            PG8_LDB(B1, 0, 1); PG8_STAGE(PG8_SB(0, 0), b2, voffB);
            PG8_BAR; PG8_WAIT_L(0); PG8_MMA(0, 1, At, B1); PG8_BAR;
            PG8_LDA(At, 0, 1); PG8_STAGE(PG8_SA(0, 0), a2, voffA);
            PG8_BAR; PG8_WAIT_L(0); PG8_MMA(1, 0, At, B0); PG8_BAR; PG8_SCHED;
            PG8_STAGE(PG8_SB(0, 1), b2 + hstepB, voffB);
            PG8_WAIT_V(6); PG8_BAR; PG8_MMA(1, 1, At, B1); PG8_BAR;
            PG8_LDB(B0, 1, 0); PG8_SCHED; PG8_LDA(At, 1, 0); PG8_STAGE(PG8_SA(0, 1), a2 + hstepA, voffA);
            PG8_WAIT_L(8); PG8_BAR; PG8_WAIT_L(0); PG8_MMA(0, 0, At, B0); PG8_BAR; PG8_SCHED;
            PG8_LDB(B1, 1, 1); PG8_STAGE(PG8_SB(1, 0), b3, voffB);
            PG8_BAR; PG8_WAIT_L(0); PG8_MMA(0, 1, At, B1); PG8_BAR;
            PG8_LDA(At, 1, 1); PG8_STAGE(PG8_SA(1, 0), a3, voffA);
            PG8_BAR; PG8_WAIT_L(0); PG8_MMA(1, 0, At, B0); PG8_BAR; PG8_SCHED;
            PG8_STAGE(PG8_SB(1, 1), b3 + hstepB, voffB);
            PG8_WAIT_V(6); PG8_BAR; PG8_MMA(1, 1, At, B1); PG8_BAR;
        }
        E(acc, cur, wr, wc, fr, fq);
        if (!has_next) break;
#pragma unroll
        for (int a = 0; a < 2; ++a)
#pragma unroll
            for (int b = 0; b < 2; ++b)
#pragma unroll
                for (int m = 0; m < 4; ++m)
#pragma unroll
                    for (int n = 0; n < 2; ++n) acc[a][b][m][n] = (f32x4){0.f, 0.f, 0.f, 0.f};
        cur = nxt; cA = nA; cB = nB; ++ui;
    }
    PG8_WAIT_V(0);
    if (wr == 0) PG8_BAR;
    PG8_BAR;
#undef PG8_SA
#undef PG8_SB
#undef PG8_STAGE
#undef PG8_LDA
#undef PG8_LDB
#undef PG8_MMA
#undef PG8_WAIT_V
#undef PG8_WAIT_L
#undef PG8_BAR
#undef PG8_SCHED
}
}
using pg8::Unit;

DI int unit_index(int i, int G, int c) { return G == 256 ? ((i * 8 + (c & 7)) * 32 + (c >> 3)) : (i * G + c); }
DI void band_decode(int U, int nM, int nN, int& pm, int& pn) { const int band = U / (4 * nN), rem = U - band * 4 * nN; const int rows = (nM - 4 * band) < 4 ? (nM - 4 * band) : 4; pn = rem / rows; pm = 4 * band + (rem - pn * rows); }
struct SchedIn {
    const char* H; const char* W; int G, c, base, limit;
    DI bool next(int i, Unit& u) const {
        const int L = base + unit_index(i, G, c); if (L >= limit) return false;
        if (L < 693) { int pm, j; band_decode(L, 33, 21, pm, j); const int pn = j < 8 ? j : j + 4; u.kind = 0; u.nt = DM / 64; u.pm = pm; u.pn = pn; u.a = H + (size_t)pm * 256 * DM * 2; u.b = W + (size_t)pn * 256 * DM * 2; }
        else { const int r = L - 693, i4 = r & 3, j = r >> 2; u.kind = 1; u.nt = DM / 64; u.pm = i4; u.pn = j; u.a = W + (size_t)(2048 + 256 * i4) * DM * 2; u.b = H + (size_t)j * 256 * DM * 2; }
        return true;
    }
};
struct SchedPlain { const char* A; const char* B; int G, c, nM, nN, total, ntK, nfull; size_t astep, bstep;
    DI bool next(int i, Unit& u) const {
        const int L = unit_index(i, G, c); if (L >= total) return false;
        if (L < nfull) { int pm, pn; band_decode(L, nM, nN, pm, pn); u.kind = 0; u.nt = ntK; u.pm = pm; u.pn = pn; u.a = A + (size_t)pm * astep; u.b = B + (size_t)pn * bstep; }
        else { const int s = L - nfull, pn = s % nN, ks = s / nN; u.kind = 2; u.nt = 4; u.pm = 32; u.pn = pn; u.ks = ks; u.a = A + (size_t)32 * astep + (size_t)ks * 512; u.b = B + (size_t)pn * bstep + (size_t)ks * 512; }
        return true;
    }
};
struct EpiIn { static constexpr bool PERM = true; bf16_t* QK; bf16_t* VT; bf16_t* ZR;
    DI void operator()(const f32x4 (&acc)[2][2][4][2], const Unit& u, int wr, int wc, int fr, int fq) const {
        bf16_t* base; int ldc, colt; const int rowt = u.pm * 256;
        if (u.kind == 0) { if (u.pn < 8) { base = QK; ldc = 2048; colt = u.pn * 256; } else { base = ZR; ldc = DSH; colt = (u.pn - 12) * 256; } }
        else { base = VT; ldc = MPAD; colt = u.pn * 256; }
        const int row0 = rowt + wr * 64 + fr, col0 = colt + wc * 32 + 8 * fq;
#pragma unroll
        for (int ai = 0; ai < 2; ++ai)
#pragma unroll
            for (int m = 0; m < 4; ++m) { bf16_t* rowp = base + (size_t)(row0 + ai * 128 + m * 16) * ldc + col0;
#pragma unroll
                for (int bj = 0; bj < 2; ++bj) { const f32x4 v0 = acc[ai][bj][m][0], v1 = acc[ai][bj][m][1];
                    u32x4 o; o.x = pk2(v0[0], v0[1]); o.y = pk2(v0[2], v0[3]); o.z = pk2(v1[0], v1[1]); o.w = pk2(v1[2], v1[3]);
                    *(u32x4*)(rowp + bj * 128) = o; } }
    }
};
struct EpiUp { static constexpr bool PERM = true; bf16_t* GV;
    DI void operator()(const f32x4 (&acc)[2][2][4][2], const Unit& u, int wr, int wc, int fr, int fq) const {
        const int row0 = u.pm * 256 + wr * 64 + fr, col0 = u.pn * 256 + wc * 32 + 8 * fq;
#pragma unroll
        for (int ai = 0; ai < 2; ++ai)
#pragma unroll
            for (int m = 0; m < 4; ++m) { bf16_t* rowp = GV + (size_t)(row0 + ai * 128 + m * 16) * (2 * DFF) + col0;
#pragma unroll
                for (int bj = 0; bj < 2; ++bj) { const f32x4 v0 = acc[ai][bj][m][0], v1 = acc[ai][bj][m][1];
                    u32x4 o; o.x = pk2(v0[0], v0[1]); o.y = pk2(v0[2], v0[3]); o.z = pk2(v1[0], v1[1]); o.w = pk2(v1[2], v1[3]);
                    *(u32x4*)(rowp + bj * 128) = o; } }
    }
};
struct EpiNull { static constexpr bool PERM = false; float* sink;
    DI void operator()(const f32x4 (&acc)[2][2][4][2], const Unit& u, int wr, int wc, int fr, int fq) const { if (acc[0][0][0][0][0] == 123456.789f) sink[0] = 1.f; }
};
template <bool RMW> struct EpiRes { static constexpr bool PERM = false; float* out; const float* xp; const float* xs; const float* MOD; int goff; float* slab;
    DI void operator()(const f32x4 (&acc)[2][2][4][2], const Unit& u, int wr, int wc, int fr, int fq) const {
        const int row0 = u.pm * 256 + wr * 64 + fr, col0 = u.pn * 256 + wc * 32 + 4 * fq;
#pragma unroll
        for (int ai = 0; ai < 2; ++ai)
#pragma unroll
            for (int m = 0; m < 4; ++m) { const int row = row0 + ai * 128 + m * 16;
                if (row < MT) {
                    const int b = row < MPR ? (row >> 11) : 4 + ((row - MPR) >> 4);
                    const float* gp = MOD + (size_t)b * NMOD + goff + col0;
                    float* op = out + (size_t)row * DM + col0;
                    const float* xr = RMW ? op : (row < MPR ? xp + (size_t)row * DM + col0 : xs + (size_t)(row - MPR) * DM + col0);
#pragma unroll
                    for (int bj = 0; bj < 2; ++bj)
#pragma unroll
                        for (int n = 0; n < 2; ++n) { const int o = bj * 128 + n * 16;
                            const f32x4 gv = *(const f32x4*)(gp + o); const f32x4 xv = __builtin_nontemporal_load((const f32x4*)(xr + o));
                            if (u.kind == 2) *(f32x4*)(slab + ((size_t)u.ks * MS + (row - MPR)) * DM + col0 + o) = acc[ai][bj][m][n];
                            else if (RMW) __builtin_nontemporal_store(xv + gv * acc[ai][bj][m][n], (f32x4*)(op + o));
                            else *(f32x4*)(op + o) = xv + gv * acc[ai][bj][m][n]; } } }
    }
};

DI void transpose_item(const float* W, int N, bf16_t* WT, int ldt, int coloff, LAS float* scr, int item, int lane) {
    const int nblk = N / 32, kb = item / nblk, nb = item % nblk, k0 = 64 * kb, n0 = 32 * nb;
#pragma unroll 8
    for (int i = 0; i < 32; ++i) { const int kk = 2 * i + (lane >> 5); scr[kk * 33 + (lane & 31)] = __builtin_nontemporal_load(W + (size_t)(k0 + kk) * N + n0 + (lane & 31)); }
    asm volatile("s_waitcnt lgkmcnt(0)" ::: "memory");
    const int c = lane & 7;
#pragma unroll
    for (int j = 0; j < 4; ++j) { const int n = (lane >> 3) + 8 * j; const LAS float* s = scr + (8 * c) * 33 + n;
        u32x4 o; o.x = pk2(s[0 * 33], s[1 * 33]); o.y = pk2(s[2 * 33], s[3 * 33]); o.z = pk2(s[4 * 33], s[5 * 33]); o.w = pk2(s[6 * 33], s[7 * 33]);
        *(u32x4*)(WT + (size_t)(n0 + n) * ldt + coloff + k0 + 8 * c) = o; }
    asm volatile("s_waitcnt lgkmcnt(0)" ::: "memory");
}
DI void phase0(const Params& p, LAS unsigned char* lds, const int tid_o) {
    const int tid = tid_o, wave = tid >> 6, lane = tid & 63, blk = blockIdx.x, G = gridDim.x;
    unsigned char* ws = p.ws;
    if (blk == 0 && tid < 64) ((unsigned*)(ws + WS_CTR))[64 + tid] = 0u;
    LAS float* sc = (LAS float*)lds;
    LAS float* red = (LAS float*)(lds + 12288);
    float* MODP = (float*)(ws + WS_MODP);
    const float* w_ada = p.in[I_WADA];
    for (int tile = blk; tile < 384; tile += G) {
        const int ct = tile % 48, kc = tile / 48;
        __syncthreads();
        for (int i = tid; i < 3072; i += 512) { const int r = i >> 8, kk = i & 255;
            const float cv = r < 4 ? p.in[I_CP][r * DM + kc * 256 + kk] : p.in[I_CS][(r - 4) * DM + kc * 256 + kk];
            sc[i] = cv / (1.f + __expf(-cv)); }
        __syncthreads();
        f32x4 acc[12];
#pragma unroll
        for (int r = 0; r < 12; ++r) acc[r] = (f32x4){0.f, 0.f, 0.f, 0.f};
        const float* wp = w_ada + (size_t)(kc * 256 + wave * 32) * NMOD + ct * 256 + lane * 4;
#pragma unroll 4
        for (int k = 0; k < 32; ++k) { const f32x4 wv = __builtin_nontemporal_load((const f32x4*)(wp + (size_t)k * NMOD));
#pragma unroll
            for (int r = 0; r < 12; ++r) acc[r] += sc[r * 256 + wave * 32 + k] * wv; }
#pragma unroll
        for (int r = 0; r < 12; ++r) *(LAS f32x4*)(red + (wave * 12 + r) * 256 + lane * 4) = acc[r];
        __syncthreads();
        for (int i = tid; i < 3072; i += 512) { const int r = i >> 8, cc = i & 255; float s = 0.f;
#pragma unroll
            for (int w = 0; w < 8; ++w) s += red[(w * 12 + r) * 256 + cc];
            MODP[(size_t)(kc * 12 + r) * NMOD + ct * 256 + cc] = s; }
    }
    __syncthreads();
    LAS float* scr = (LAS float*)(lds + wave * 16384);
    const int gw = blk * 8 + wave, NGW = G * 8;
    constexpr int I_IN = 32 * 200, I_OUT = 32 * 64, I_UP = 32 * 352, I_DN = 88 * 64, I_L = 32;
    constexpr int NITEMS = I_IN + I_OUT + I_UP + I_DN + 4 * I_L;
    for (int it = gw; it < NITEMS; it += NGW) {
        int r = it;
        if (r < I_IN) { transpose_item(p.in[I_WIN], DIN, (bf16_t*)(ws + WS_WT_IN), DM, 0, scr, r, lane); continue; } r -= I_IN;
        if (r < I_OUT) { transpose_item(p.in[I_WOUT], DM, (bf16_t*)(ws + WS_WT_OUT), DM, 0, scr, r, lane); continue; } r -= I_OUT;
        if (r < I_UP) { transpose_item(p.in[I_WUP], 2 * DFF, (bf16_t*)(ws + WS_WT_UP), DM, 0, scr, r, lane); continue; } r -= I_UP;
        if (r < I_DN) { transpose_item(p.in[I_WDN], DM, (bf16_t*)(ws + WS_WT_DOWN), DFF, 0, scr, r, lane); continue; } r -= I_DN;
        if (r < I_L) { transpose_item(p.in[I_W2], 1024, (bf16_t*)(ws + WS_LT), 256, 0, scr, r, lane); continue; } r -= I_L;
        if (r < I_L) { transpose_item(p.in[I_A2], 1024, (bf16_t*)(ws + WS_LT), 256, 64, scr, r, lane); continue; } r -= I_L;
        transpose_item(p.in[I_G2], 1024, (bf16_t*)(ws + WS_LT), 256, 128, scr, r, lane);
    }
}

DI void deferred_convert(const Params& p, LAS unsigned char* lds, const int tid_o) {
    const int wave = __builtin_amdgcn_readfirstlane(tid_o >> 6), lane = tid_o & 63;
    unsigned char* ws = p.ws; unsigned* ctr = (unsigned*)(ws + WS_CTR) + 64;
    LAS float* scr = (LAS float*)(lds + wave * 16384);
    constexpr int I_OUT = 32 * 64, I_UP = 32 * 352, I_DN = 88 * 64;
    for (;;) { unsigned t = 0; if (lane == 0) t = atomicAdd(ctr, 1u); int r = (int)__builtin_amdgcn_readfirstlane(t); if (r >= I_OUT + I_UP + I_DN) break;
        if (r < I_OUT) { transpose_item(p.in[I_WOUT], DM, (bf16_t*)(ws + WS_WT_OUT), DM, 0, scr, r, lane); continue; } r -= I_OUT;
        if (r < I_UP) { transpose_item(p.in[I_WUP], 2 * DFF, (bf16_t*)(ws + WS_WT_UP), DM, 0, scr, r, lane); continue; } r -= I_UP;
        transpose_item(p.in[I_WDN], DM, (bf16_t*)(ws + WS_WT_DOWN), DFF, 0, scr, r, lane); }
}

template <int WHICH> DI void phase_norm(const Params& p, LAS unsigned char* lds, const int tid_o) {
    const int tid = tid_o, wave = tid >> 6, lane = tid & 63, blk = blockIdx.x, G = gridDim.x;
    unsigned char* ws = p.ws;
    const float* MODP = (const float*)(ws + WS_MODP); float* MOD = (float*)(ws + WS_MOD);
    const float* b_ada = p.in[I_BADA];
    if (WHICH == 0) {
        for (int r = blk; r < 12; r += G)
            for (int j = tid; j < NMOD; j += 512) { float s = b_ada[j];
#pragma unroll
                for (int pp = 0; pp < 8; ++pp) s += MODP[(size_t)(pp * 12 + r) * NMOD + j];
                MOD[(size_t)r * NMOD + j] = s; }
    }
    LAS float* Al = (LAS float*)lds; LAS float* Bl = Al + DM;
    const float* gamma = WHICH == 0 ? p.in[I_NAG] : p.in[I_NFG];
    bf16_t* H = (bf16_t*)(ws + WS_H);
    for (int chunk = blk; chunk < 264; chunk += G) {
        const int b = chunk < 256 ? (chunk >> 6) : 4 + (chunk - 256);
        __syncthreads();
        for (int j = tid; j < DM; j += 512) { float scv, shv;
            if (WHICH == 0) { scv = b_ada[DM + j]; shv = b_ada[j];
#pragma unroll
                for (int pp = 0; pp < 8; ++pp) { scv += MODP[(size_t)(pp * 12 + b) * NMOD + DM + j]; shv += MODP[(size_t)(pp * 12 + b) * NMOD + j]; } }
            else { scv = MOD[(size_t)b * NMOD + 4 * DM + j]; shv = MOD[(size_t)b * NMOD + 3 * DM + j]; }
            Al[j] = gamma[j] * (1.f + scv); Bl[j] = shv; }
        __syncthreads();
        const int nrows = chunk < 256 ? 32 : 16, row0 = chunk < 256 ? chunk * 32 : MPR + (chunk - 256) * 16;
        if (WHICH == 1 && chunk >= 256) {
            const float* slab = (const float*)(ws + WS_FV);
            for (int i = tid; i < 16 * DM / 4; i += 512) { const int r = i >> 9, c4 = (i & 511) * 4; const int m = row0 + r; f32x4 sum = (f32x4){0.f, 0.f, 0.f, 0.f};
#pragma unroll
                for (int ks = 0; ks < 8; ++ks) sum += *(const f32x4*)(slab + ((size_t)ks * MS + (m - MPR)) * DM + c4);
                const f32x4 g = *(const f32x4*)(MOD + (size_t)b * NMOD + 2 * DM + c4); f32x4* op = (f32x4*)(p.out + (size_t)m * DM + c4); *op = *op + g * sum; }
            __syncthreads();
        }
        const int nr = nrows >> 3;
        for (int rp = 0; rp < nr; rp += 2) {
            f32x4 v[2][8]; float ss[2] = {0.f, 0.f};
#pragma unroll
            for (int q = 0; q < 2; ++q) { const int m = row0 + wave + 8 * (rp + q);
                const float* xr = WHICH == 0 ? (m < MPR ? p.in[I_XP] + (size_t)m * DM : p.in[I_XS] + (size_t)(m - MPR) * DM) : p.out + (size_t)m * DM;
#pragma unroll
                for (int j = 0; j < 8; ++j) v[q][j] = __builtin_nontemporal_load((const f32x4*)(xr + j * 256 + lane * 4)); }
#pragma unroll
            for (int q = 0; q < 2; ++q) {
#pragma unroll
                for (int j = 0; j < 8; ++j) ss[q] += v[q][j].x * v[q][j].x + v[q][j].y * v[q][j].y + v[q][j].z * v[q][j].z + v[q][j].w * v[q][j].w; }
#pragma unroll
            for (int q = 0; q < 2; ++q) { const int m = row0 + wave + 8 * (rp + q);
                const float rstd = rsqrtf(wave_sum(ss[q]) * (1.f / DM) + 1e-6f);
#pragma unroll
                for (int j = 0; j < 8; ++j) { const int idx = j * 256 + lane * 4; const f32x4 a4 = *(const LAS f32x4*)(Al + idx), b4 = *(const LAS f32x4*)(Bl + idx);
                    const f32x4 o = v[q][j] * rstd * a4 + b4; u32x2 qq; qq.x = pk2(o.x, o.y); qq.y = pk2(o.z, o.w);
                    *(u32x2*)(H + (size_t)m * DM + idx) = qq; } }
        }
    }
}

DI void load_zs(const Params& p, const bf16_t* ZR, int m, int c, int n, float* o) {
    const bool samp = m >= MPR; const int t = samp ? ((m - MPR) & 15) : (m & (SEQ - 1)); const int bs = samp ? ((m - MPR) >> 4) : 0;
    const int mp = t > 0 ? m - 1 : m;
    float z[8], zp[8], st[8];
    if (n == 8) { unpack8(*(const u32x4*)(ZR + (size_t)m * DSH + c), z); unpack8(*(const u32x4*)(ZR + (size_t)mp * DSH + c), zp);
        const f32x4 s0 = *(const f32x4*)(p.in[I_SS] + (size_t)bs * DSH + c), s1 = *(const f32x4*)(p.in[I_SS] + (size_t)bs * DSH + c + 4);
        st[0] = s0.x; st[1] = s0.y; st[2] = s0.z; st[3] = s0.w; st[4] = s1.x; st[5] = s1.y; st[6] = s1.z; st[7] = s1.w; }
    else { unpack4(*(const u32x2*)(ZR + (size_t)m * DSH + c), z); unpack4(*(const u32x2*)(ZR + (size_t)mp * DSH + c), zp);
        const f32x4 s0 = *(const f32x4*)(p.in[I_SS] + (size_t)bs * DSH + c); st[0] = s0.x; st[1] = s0.y; st[2] = s0.z; st[3] = s0.w; }
    const float* mu = p.in[I_MU] + c;
#pragma unroll
    for (int j = 0; j < n; ++j) { const float pv = t > 0 ? zp[j] : (samp ? st[j] : 0.f); o[j] = z[j] + (pv - z[j]) * mu[j]; }
}
DI void phase_prep(const Params& p, LAS unsigned char* lds, const int tid_o) {
    const int tid = tid_o, wave = tid >> 6, lane = tid & 63, blk = blockIdx.x, G = gridDim.x;
    unsigned char* ws = p.ws; float* out = p.out;
    bf16_t* QK = (bf16_t*)(ws + WS_QK); const bf16_t* VT = (const bf16_t*)(ws + WS_VT); const bf16_t* ZR = (const bf16_t*)(ws + WS_ZR);
    const int gw = blk * 8 + wave, NGW = G * 8;
    if (blk == 0 && tid >= 128 && tid < 256) ((unsigned*)(ws + WS_CTR))[tid] = 0u;
    if (G == 256) {
        SchedIn S; S.H = (const char*)(ws + WS_H); S.W = (const char*)(ws + WS_WT_IN); S.G = G; S.c = blk; S.base = 768; S.limit = 825;
        EpiIn E; E.QK = (bf16_t*)(ws + WS_QK); E.VT = (bf16_t*)(ws + WS_VT); E.ZR = (bf16_t*)(ws + WS_ZR);
        pg8::gemm_phase(lds, pg8::GemmK{DM, DM, DM}, S, E, tid_o);
        __syncthreads();
    }
    for (int m = gw; m < MT; m += NGW) {
        int lane_o = lane; asm volatile("" : "+v"(lane_o));
#pragma unroll
        for (int it = 0; it < 4; ++it) { const int col = it * 512 + lane_o * 8;
            float x[8]; unpack8(*(const u32x4*)(QK + (size_t)m * 2048 + col), x);
            float ss = 0.f;
#pragma unroll
            for (int j = 0; j < 8; ++j) ss += x[j] * x[j];
            ss += __shfl_xor(ss, 1); ss += __shfl_xor(ss, 2); ss += __shfl_xor(ss, 4);
            const float rstd = rsqrtf(ss * (1.f / 64.f) + 1e-6f);
            const bool isk = col >= 1024; const float* g = (isk ? p.in[I_KG] : p.in[I_QG]) + (col & 63);
            float y[8];
#pragma unroll
            for (int j = 0; j < 8; ++j) y[j] = x[j] * rstd * g[j];
            if (isk) {
                const int hc = col - 1024;
                float* op = nullptr;
                if (m >= MPR) op = out + O_KS + (size_t)(m - MPR) * 1024 + hc;
                else { const int t = m & (SEQ - 1), b = m >> 11; if (t >= SEQ - 512) op = out + O_KP + ((size_t)b * 512 + (t - (SEQ - 512))) * 1024 + hc; }
                if (op) { *(f32x4*)op = (f32x4){y[0], y[1], y[2], y[3]}; *(f32x4*)(op + 4) = (f32x4){y[4], y[5], y[6], y[7]}; }
            } else {
#pragma unroll
                for (int j = 0; j < 8; ++j) y[j] *= 0.125f;
            }
            u32x4 o; o.x = pk2(y[0], y[1]); o.y = pk2(y[2], y[3]); o.z = pk2(y[4], y[5]); o.w = pk2(y[6], y[7]);
            *(u32x4*)(QK + (size_t)m * 2048 + col) = o; }
    }
#if REPEAT_SUB == 3
    for (int rep3 = 0; rep3 < 2; ++rep3) {
#else
    {
#endif
    { bf16_t* KC = (bf16_t*)(ws + WS_KC); bf16_t* VTC = (bf16_t*)(ws + WS_VTC);
      for (int i = blk * 512 + tid; i < 8 * 512 * 1024 / 8; i += G * 512) { const f32x4 a0 = __builtin_nontemporal_load((const f32x4*)(p.in[I_CK] + (size_t)i * 8)), a1 = __builtin_nontemporal_load((const f32x4*)(p.in[I_CK] + (size_t)i * 8 + 4));
          u32x4 o; o.x = pk2(a0.x, a0.y); o.y = pk2(a0.z, a0.w); o.z = pk2(a1.x, a1.y); o.w = pk2(a1.z, a1.w); *(u32x4*)(KC + (size_t)i * 8) = o; }
      for (int task = gw; task < 8 * 16 * 8; task += NGW) { const int jb = task & 7, cb = (task >> 3) & 15, b = task >> 7; const int c = cb * 64 + lane;
          float v[64];
#pragma unroll
          for (int j = 0; j < 64; ++j) v[j] = __builtin_nontemporal_load(p.in[I_CV] + ((size_t)b * 512 + jb * 64 + j) * 1024 + c);
#pragma unroll
          for (int q = 0; q < 8; ++q) { u32x4 o; o.x = pk2(v[8 * q], v[8 * q + 1]); o.y = pk2(v[8 * q + 2], v[8 * q + 3]); o.z = pk2(v[8 * q + 4], v[8 * q + 5]); o.w = pk2(v[8 * q + 6], v[8 * q + 7]);
              *(u32x4*)(VTC + ((size_t)b * 1024 + c) * 512 + jb * 64 + 8 * q) = o; } }
    }
    { const size_t gt = (size_t)blk * 512 + tid, NT = (size_t)G * 512;
      for (size_t i = gt; i < (size_t)12 * DSH; i += NT) { const int r = (int)(i / DSH), c = (int)(i % DSH);
          if (r < 4) out[O_SHP + (size_t)r * DSH + c] = bf1(ZR[(size_t)(r * SEQ + SEQ - 1) * DSH + c]);
          else out[O_SHS + (size_t)(r - 4) * DSH + c] = bf1(ZR[(size_t)(MPR + (r - 4) * 16 + 15) * DSH + c]); }
    }
    const bf16_t* LT = (const bf16_t*)(ws + WS_LT);
    float* FW = (float*)(ws + WS_FW); bf16_t* FB = (bf16_t*)(ws + WS_FB); bf16_t* FV = (bf16_t*)(ws + WS_FV); bf16_t* GG = (bf16_t*)(ws + WS_GG); float* BON = (float*)(ws + WS_BONUS);
    const float* SSH = p.in[I_SS]; const float* MU = p.in[I_MU];
    LAS unsigned char* Ap = lds;
    LAS bf16_t* zt = (LAS bf16_t*)(lds + 16896 + wave * 13200);
    const int n0 = lane & 31, hf0 = lane >> 5;
    for (;;) {
        LAS int* tslot = (LAS int*)(lds + 130944);
        __syncthreads();
        if (tid == 0) *tslot = (int)atomicAdd((unsigned*)(ws + WS_CTR) + 64, 1u);
        __syncthreads();
        const int task = *tslot; if (task >= 520) break;
        const int m0 = (task >> 1) * 32; const bool samp = m0 >= MPR;
        int hf = hf0; asm volatile("" : "+v"(hf));
        __syncthreads();
        {
            const int tk = tid >> 4, cc = (tid & 15) * 16; const int m = m0 + tk;
            const int t = samp ? ((m - MPR) & 15) : (m & (SEQ - 1)); const int bs = samp ? ((m - MPR) >> 4) : 0; const int mp = t > 0 ? m - 1 : m;
            float z[16], zp[16];
            unpack8(*(const u32x4*)(ZR + (size_t)m * DSH + 3072 + cc), z); unpack8(*(const u32x4*)(ZR + (size_t)m * DSH + 3072 + cc + 8), z + 8);
            unpack8(*(const u32x4*)(ZR + (size_t)mp * DSH + 3072 + cc), zp); unpack8(*(const u32x4*)(ZR + (size_t)mp * DSH + 3072 + cc + 8), zp + 8);
            float o[16];
#pragma unroll
            for (int j4 = 0; j4 < 4; ++j4) { const f32x4 mu4 = *(const f32x4*)(MU + 3072 + cc + 4 * j4), st4 = *(const f32x4*)(SSH + (size_t)bs * DSH + 3072 + cc + 4 * j4);
#pragma unroll
                for (int e = 0; e < 4; ++e) { const int j = 4 * j4 + e; const float pv = t > 0 ? zp[j] : (samp ? st4[e] : 0.f); float v = z[j] + (pv - z[j]) * mu4[e];
                    if (cc < 64) v = 1.f - 2.f / (1.f + __expf(2.f * v)); else if (cc >= 128) v = sigmoidf_(v);
                    o[j] = v; } }
            u32x4 q0, q1; q0.x = pk2(o[0], o[1]); q0.y = pk2(o[2], o[3]); q0.z = pk2(o[4], o[5]); q0.w = pk2(o[6], o[7]); q1.x = pk2(o[8], o[9]); q1.y = pk2(o[10], o[11]); q1.z = pk2(o[12], o[13]); q1.w = pk2(o[14], o[15]);
            *(LAS u32x4*)(Ap + tk * 528 + cc * 2) = q0; *(LAS u32x4*)(Ap + tk * 528 + cc * 2 + 16) = q1;
        }
        __syncthreads();
        bf16x8 Bf[16];
#pragma unroll
        for (int s = 0; s < 16; ++s) Bf[s] = *(const LAS bf16x8*)(Ap + n0 * 528 + (16 * s + 8 * hf) * 2);
#pragma unroll 1
        for (int hh = (task & 1); hh <= (task & 1); ++hh) { const int h = wave * 2 + hh;
            int n = n0; asm volatile("" : "+v"(hf), "+v"(n));
            for (int q = lane; q < 33 * 24; q += 64) { const int row = q / 24, seg = q - row * 24, vec = seg >> 3, part = seg & 7; int mr = m0 - 1 + row; mr = mr < 0 ? 0 : mr;
                *(LAS u32x4*)(zt + row * 200 + vec * 64 + part * 8) = *(const u32x4*)(ZR + (size_t)mr * DSH + vec * 1024 + h * 64 + part * 8); }
#pragma unroll 1
            for (int b2 = 0; b2 < 2; ++b2) { f32x16 ag; for (int i = 0; i < 16; ++i) ag[i] = 0.f;
                const int c = h * 64 + b2 * 32 + n; const bf16_t* lt = LT + (size_t)c * 256 + 8 * hf;
#pragma unroll
                for (int s = 8; s < 16; ++s) ag = MFMA32(Bf[s], *(const bf16x8*)(lt + 16 * s), ag);
#pragma unroll
                for (int i = 0; i < 16; ++i) GG[(size_t)(m0 + crow(i, hf)) * 1024 + c] = (bf16_t)(pk2(ag[i], 0.f) & 0xffffu); }
#define ZS(vec, cl, i, muv, stv) ({ const int ti_ = crow(i, hf); const float z_ = bf1(zt[(ti_ + 1) * 200 + (vec) * 64 + (cl)]); float pv_ = bf1(zt[ti_ * 200 + (vec) * 64 + (cl)]); \
                if ((i) == 0 || (i) == 8) { const int m_ = m0 + ti_; const int t_ = samp ? ((m_ - MPR) & 15) : (m_ & (SEQ - 1)); if (t_ == 0) pv_ = samp ? (stv) : 0.f; } z_ + (pv_ - z_) * (muv); })
            float ssq[16];
#pragma unroll
            for (int i = 0; i < 16; ++i) ssq[i] = 0.f;
#pragma unroll
            for (int b2 = 0; b2 < 2; ++b2) { const int cl = b2 * 32 + n, c = h * 64 + cl; const float kkw = p.in[I_KK][c], muk = MU[1024 + c];
                const int bs0 = samp ? ((m0 - MPR) >> 4) : 0; const float st0 = SSH[(size_t)bs0 * DSH + 1024 + c], st1 = SSH[(size_t)(samp ? bs0 + 1 : 0) * DSH + 1024 + c];
#pragma unroll
                for (int i = 0; i < 16; ++i) { const float kv = ZS(1, cl, i, muk, (i == 0 ? st0 : st1)); const float q = kv * kkw; ssq[i] += q * q; } }
            float inv[16];
#pragma unroll
            for (int i = 0; i < 16; ++i) { float v = row16_sum(ssq[i]); v += __shfl_xor(v, 16); inv[i] = 1.f / fmaxf(sqrtf(v), 1e-12f); }
            float bon[16];
#pragma unroll
            for (int i = 0; i < 16; ++i) bon[i] = 0.f;
#pragma unroll 1
            for (int b2 = 0; b2 < 2; ++b2) { asm volatile("" : "+v"(hf), "+v"(n)); const int cl = b2 * 32 + n, c = h * 64 + cl;
                f32x16 aw, aa; for (int i = 0; i < 16; ++i) { aw[i] = 0.f; aa[i] = 0.f; }
                const bf16_t* lt = LT + (size_t)c * 256 + 8 * hf;
#pragma unroll
                for (int s = 0; s < 4; ++s) aw = MFMA32(Bf[s], *(const bf16x8*)(lt + 16 * s), aw);
#pragma unroll
                for (int s = 4; s < 8; ++s) aa = MFMA32(Bf[s], *(const bf16x8*)(lt + 16 * s), aa);
                const float w0 = p.in[I_W0][c], a0 = p.in[I_A0][c], kkw = p.in[I_KK][c], kaw = p.in[I_KA][c], rkw = p.in[I_RK][c], mur = MU[c], muk = MU[1024 + c], muv = MU[2048 + c];
                const int bs0 = samp ? ((m0 - MPR) >> 4) : 0, bs1 = samp ? bs0 + 1 : 0;
                const float sr0 = SSH[(size_t)bs0 * DSH + c], sr1 = SSH[(size_t)bs1 * DSH + c], sk0 = SSH[(size_t)bs0 * DSH + 1024 + c], sk1 = SSH[(size_t)bs1 * DSH + 1024 + c], sv0 = SSH[(size_t)bs0 * DSH + 2048 + c], sv1 = SSH[(size_t)bs1 * DSH + 2048 + c];
#pragma unroll
                for (int i = 0; i < 16; ++i) { const int m = m0 + crow(i, hf);
                    const float rz = ZS(0, cl, i, mur, (i == 0 ? sr0 : sr1)), kv = ZS(1, cl, i, muk, (i == 0 ? sk0 : sk1)), vz = ZS(2, cl, i, muv, (i == 0 ? sv0 : sv1));
                    const float wl = w0 + aw[i];
                    const float y = -wl; const float sp = fmaxf(y, 0.f) + __logf(1.f + __expf(-fabsf(y)));
                    const float dec = __expf(-__expf(-sp - 0.5f));
                    const float av = sigmoidf_(a0 + aa[i]);
                    const float kk = kv * kkw * inv[i], kp = kv * (1.f + (av - 1.f) * kaw), kka = kk * av;
                    bon[i] += rz * kp * rkw;
                    FW[((size_t)m * 16 + h) * 64 + cl] = dec;
                    bf16_t* fb = FB + ((size_t)m * 16 + h) * 256 + cl;
                    fb[0] = (bf16_t)(pk2(rz, 0.f) & 0xffffu); fb[64] = (bf16_t)(pk2(kp, 0.f) & 0xffffu); fb[128] = (bf16_t)(pk2(kk, 0.f) & 0xffffu); fb[192] = (bf16_t)(pk2(kka, 0.f) & 0xffffu);
                    FV[(size_t)m * 1024 + c] = (bf16_t)(pk2(vz, 0.f) & 0xffffu); __builtin_amdgcn_sched_barrier(0); }
            }
#undef ZS
#pragma unroll
            for (int i = 0; i < 16; ++i) { float v = row16_sum(bon[i]); v += __shfl_xor(v, 16); if (n == 0) BON[(size_t)(m0 + crow(i, hf)) * 16 + h] = v; }
        }
    }
    }
}

constexpr int SC_TC = 16, SC_NB = 4, SC_BUFB = SC_TC * 1280 + SC_TC * 64;
constexpr int L_FLAGS = SC_NB * SC_BUFB, L_TBL = L_FLAGS + 64, L_KV = L_TBL + 8 * 1040, KV_STRIDE = 144, KV_BYTES = 2 * 64 * KV_STRIDE;
DI void scan_run(const Params& p, LAS unsigned char* lds, const int wave, const int lane, const int blk, const int G) {
    unsigned char* ws = p.ws; float* out = p.out;
    const float* FW = (const float*)(ws + WS_FW); const bf16_t* FB = (const bf16_t*)(ws + WS_FB); const bf16_t* FV = (const bf16_t*)(ws + WS_FV); float* Y = (float*)(ws + WS_Y);
    LAS unsigned* ready = (LAS unsigned*)(lds + L_FLAGS); LAS unsigned* done = ready + SC_NB;
    unsigned gc = 0;
    for (int u = blk; u < 768; u += G) {
        int m0, T, h, rg; const float* S0; float* Sout;
        if (u < 256) { const int bh = u >> 2; rg = u & 3; h = bh & 15; m0 = (bh >> 4) * SEQ; T = SEQ; S0 = nullptr; Sout = out + O_SP + (size_t)bh * 4096; }
        else { const int su = u - 256, bh = su >> 2; rg = su & 3; h = bh & 15; m0 = MPR + (bh >> 4) * 16; T = 16; S0 = p.in[I_SR] + (size_t)bh * 4096; Sout = out + O_SS + (size_t)bh * 4096; }
        const int nch = T / SC_TC;
        if (wave >= 4) {
            const int lw = wave - 4; const int cstart = (int)((gc + (unsigned)lw) & 1u); const int nmine = (nch - cstart + 1) >> 1;
            f32x4 fw[3][4]; u32x4 fb[3][8]; u32x4 fv[3];
#define FEED_ISSUE(slot, jidx) do { const int _j = (jidx) < nmine ? (jidx) : nmine - 1; const int _mb = m0 + (cstart + 2 * _j) * SC_TC; \
                _Pragma("unroll") for (int i = 0; i < 4; ++i) { const int idx = i * 64 + lane, st = idx >> 4, q = idx & 15; fw[slot][i] = __builtin_nontemporal_load((const f32x4*)(FW + ((size_t)(_mb + st) * 16 + h) * 64 + q * 4)); } \
                _Pragma("unroll") for (int i = 0; i < 8; ++i) { const int idx = i * 64 + lane, st = idx >> 5, q = idx & 31; fb[slot][i] = __builtin_nontemporal_load((const u32x4*)(FB + ((size_t)(_mb + st) * 16 + h) * 256 + q * 8)); } \
                fv[slot] = *(const u32x4*)(FV + (size_t)(_mb + ((lane & 31) >> 1)) * 1024 + h * 64 + rg * 16 + (lane & 1) * 8); } while (0)
            if (nmine > 0) {
                FEED_ISSUE(0, 0); FEED_ISSUE(1, 1);
                for (int j0 = 0; j0 < nmine; j0 += 3) {
#pragma unroll
                    for (int jj = 0; jj < 3; ++jj) { const int j = j0 + jj;
                        if (j < nmine) {
                            FEED_ISSUE((jj + 2) % 3, j + 2);
                            const unsigned g = gc + (unsigned)(cstart + 2 * j); const int b = g & (SC_NB - 1);
                            if (g >= SC_NB) { const unsigned target = 4u * (g / SC_NB); while (__hip_atomic_load(done + b, __ATOMIC_RELAXED, __HIP_MEMORY_SCOPE_WORKGROUP) < target) __builtin_amdgcn_s_sleep(1); asm volatile("" ::: "memory"); }
                            LAS unsigned char* buf = lds + b * SC_BUFB;
#pragma unroll
                            for (int i = 0; i < 4; ++i) { const int idx = i * 64 + lane, st = idx >> 4, q = idx & 15; *(LAS f32x4*)(buf + st * 1280 + q * 16) = fw[jj][i]; }
#pragma unroll
                            for (int i = 0; i < 8; ++i) { const int idx = i * 64 + lane, st = idx >> 5, q = idx & 31; float f[8]; unpack8(fb[jj][i], f);
                                LAS float* d = (LAS float*)(buf + st * 1280 + 256 + q * 32); *(LAS f32x4*)d = (f32x4){f[0], f[1], f[2], f[3]}; *(LAS f32x4*)(d + 4) = (f32x4){f[4], f[5], f[6], f[7]}; }
                            if (lane < 32) { float f[8]; unpack8(fv[jj], f); LAS float* d = (LAS float*)(buf + SC_TC * 1280 + (lane >> 1) * 64 + (lane & 1) * 32);
                                *(LAS f32x4*)d = (f32x4){f[0], f[1], f[2], f[3]}; *(LAS f32x4*)(d + 4) = (f32x4){f[4], f[5], f[6], f[7]}; }
                            asm volatile("" ::: "memory");
                            if (lane == 0) __hip_atomic_store(ready + b, g + 1u, __ATOMIC_RELAXED, __HIP_MEMORY_SCOPE_WORKGROUP);
                            asm volatile("" ::: "memory");
                        }
                    }
                }
            }
#undef FEED_ISSUE
        } else {
            const int rl = wave * 4 + (lane >> 4), kq = lane & 15, row = rg * 16 + rl;
            f32x2 Sa = (f32x2){0.f, 0.f}, Sb = (f32x2){0.f, 0.f};
            if (S0) { const f32x4 s4 = *(const f32x4*)(S0 + row * 64 + kq * 4); Sa = (f32x2){s4.x, s4.y}; Sb = (f32x2){s4.z, s4.w}; }
            for (int c = 0; c < nch; ++c) { const unsigned g = gc + c; const int b = g & (SC_NB - 1);
                while (__hip_atomic_load(ready + b, __ATOMIC_RELAXED, __HIP_MEMORY_SCOPE_WORKGROUP) < g + 1u) __builtin_amdgcn_s_sleep(1);
                asm volatile("" ::: "memory");
                const LAS unsigned char* buf = lds + b * SC_BUFB;
                float ykeep = 0.f;
                f32x4 W_[3], R_[3], K_[3], KK_[3], KA_[3]; float V_[3];
#define SC_LOAD(slot, st) do { const LAS unsigned char* sb = buf + (st) * 1280 + kq * 16; W_[slot] = *(const LAS f32x4*)(sb); R_[slot] = *(const LAS f32x4*)(sb + 256); K_[slot] = *(const LAS f32x4*)(sb + 512); \
                    KK_[slot] = *(const LAS f32x4*)(sb + 768); KA_[slot] = *(const LAS f32x4*)(sb + 1024); V_[slot] = *(const LAS float*)(buf + SC_TC * 1280 + (st) * 64 + rl * 4); } while (0)
                SC_LOAD(0, 0); SC_LOAD(1, 1); SC_LOAD(2, 2);
#pragma unroll
                for (int st = 0; st < SC_TC; ++st) { const int sl = st % 3;
                    const f32x4 w4 = W_[sl], r4 = R_[sl], k4 = K_[sl], kk4 = KK_[sl], ka4 = KA_[sl]; const float vv = V_[sl];
                    f32x2 p2 = Sa * (f32x2){kk4.x, kk4.y}; p2 = Sb * (f32x2){kk4.z, kk4.w} + p2;
                    float pa = p2.x + p2.y; pa = row16_sum(pa);
                    const f32x2 Ta = Sa * (f32x2){w4.x, w4.y} + vv * (f32x2){k4.x, k4.y}, Tb = Sb * (f32x2){w4.z, w4.w} + vv * (f32x2){k4.z, k4.w};
                    Sa = Ta - pa * (f32x2){ka4.x, ka4.y}; Sb = Tb - pa * (f32x2){ka4.z, ka4.w};
                    f32x2 q2 = Sa * (f32x2){r4.x, r4.y}; q2 = Sb * (f32x2){r4.z, r4.w} + q2;
                    float qy = q2.x + q2.y; qy = row16_sum(qy);
                    ykeep = (kq == st) ? qy : ykeep;
                    if (st + 3 < SC_TC) SC_LOAD(sl, st + 3);
                }
#undef SC_LOAD
                asm volatile("" ::: "memory");
                if (lane == 0) __hip_atomic_fetch_add(done + b, 1u, __ATOMIC_RELAXED, __HIP_MEMORY_SCOPE_WORKGROUP);
                asm volatile("" ::: "memory");
                Y[(size_t)(m0 + c * SC_TC + kq) * 1024 + h * 64 + row] = ykeep;
            }
            *(f32x4*)(Sout + row * 64 + kq * 4) = (f32x4){Sa.x, Sa.y, Sb.x, Sb.y};
        }
        gc += nch;
    }
}

DI void attn_wave_task(const Params& p, LAS float* tbl, LAS unsigned char* kv, const int task, const int lane) {
    unsigned char* ws = p.ws;
    const bf16_t* QK = (const bf16_t*)(ws + WS_QK); const bf16_t* VT = (const bf16_t*)(ws + WS_VT); bf16_t* MIX = (bf16_t*)(ws + WS_MIXIN);
    const int c = 31 - (task >> 7), rem = task & 127, b = rem >> 5, h = (rem >> 1) & 15, half = rem & 1;
    for (int i = lane; i < 257; i += 64) tbl[i] = p.in[I_RB][h * 257 + i] * LOG2E;
    const int n = lane & 31, hf = lane >> 5;
    const int mq = b * SEQ + c * 64 + half * 32 + n;
    bf16x8 Qf[4];
#pragma unroll
    for (int s = 0; s < 4; ++s) Qf[s] = *(const bf16x8*)(QK + (size_t)mq * 2048 + h * 64 + 16 * s + 8 * hf);
    f32x16 O[2]; for (int i = 0; i < 16; ++i) { O[0][i] = 0.f; O[1][i] = 0.f; }
    float mrun = -1e30f, lrun = 0.f;
    const int kc0 = c - 8 < 0 ? 0 : c - 8;
    LAS unsigned char* kt = kv; LAS unsigned char* vt = kv + 64 * KV_STRIDE;
    const int srow = lane >> 3, spc = lane & 7;
    u32x4 kreg[8], vreg[8];
#define KV_FETCH(kcx) do { const bf16_t* kg = QK + (size_t)(b * SEQ + (kcx) * 64 + srow) * 2048 + 1024 + h * 64 + spc * 8; const bf16_t* vg = VT + (size_t)(h * 64 + srow) * MPAD + (size_t)b * SEQ + (kcx) * 64 + spc * 8; \
        _Pragma("unroll") for (int i = 0; i < 8; ++i) { kreg[i] = *(const u32x4*)(kg + (size_t)i * 8 * 2048); vreg[i] = *(const u32x4*)(vg + (size_t)i * 8 * MPAD); } } while (0)
#define KV_STORE() do { _Pragma("unroll") for (int i = 0; i < 8; ++i) { *(LAS u32x4*)(kt + (i * 8 + srow) * KV_STRIDE + spc * 16) = kreg[i]; *(LAS u32x4*)(vt + (i * 8 + srow) * KV_STRIDE + spc * 16) = vreg[i]; } } while (0)
    KV_FETCH(kc0);
    KV_STORE();
    for (int kc = kc0; kc <= c; ++kc) {
        { const int kn = kc < c ? kc + 1 : kc; KV_FETCH(kn); }
        f32x16 Sx[2];
#pragma unroll
        for (int kb = 0; kb < 2; ++kb) { for (int i = 0; i < 16; ++i) Sx[kb][i] = 0.f;
#pragma unroll
            for (int s = 0; s < 4; ++s) Sx[kb] = MFMA32(*(const LAS bf16x8*)(kt + (kb * 32 + n) * KV_STRIDE + 16 * hf + 32 * s), Qf[s], Sx[kb]); }
        const int dist0 = (c - kc) * 64 + half * 32 + n;
        float mx = -1e30f; float ebias = 0.f; const bool far = c - kc >= 3;
        if (far) { ebias = tbl[256];
#pragma unroll
            for (int kb = 0; kb < 2; ++kb)
#pragma unroll
                for (int i = 0; i < 16; ++i) mx = fmaxf(mx, Sx[kb][i]);
            mx = mx * LOG2E + ebias; }
        else {
#pragma unroll
            for (int kb = 0; kb < 2; ++kb)
#pragma unroll
                for (int i = 0; i < 16; ++i) { int rel = dist0 - kb * 32 - crow(i, hf); rel = rel < -128 ? -128 : (rel > 128 ? 128 : rel);
                    Sx[kb][i] = Sx[kb][i] * LOG2E + tbl[rel + 128]; mx = fmaxf(mx, Sx[kb][i]); } }
        mx = fmaxf(mx, __shfl_xor(mx, 32));
        const float mnew = fmaxf(mrun, mx); const float alpha = __builtin_amdgcn_exp2f(mrun - mnew); mrun = mnew;
        float ls = 0.f; const float esc = far ? LOG2E : 1.f, eoff = (far ? ebias : 0.f) - mnew;
#pragma unroll
        for (int kb = 0; kb < 2; ++kb)
#pragma unroll
            for (int i = 0; i < 16; ++i) { Sx[kb][i] = __builtin_amdgcn_exp2f(Sx[kb][i] * esc + eoff); ls += Sx[kb][i]; }
        lrun = lrun * alpha + ls;
#pragma unroll
        for (int i = 0; i < 16; ++i) { O[0][i] *= alpha; O[1][i] *= alpha; }
#pragma unroll
        for (int kb = 0; kb < 2; ++kb)
#pragma unroll
            for (int s2 = 0; s2 < 2; ++s2) {
                u32x4 pp; pp.x = pk2(Sx[kb][8 * s2], Sx[kb][8 * s2 + 1]); pp.y = pk2(Sx[kb][8 * s2 + 2], Sx[kb][8 * s2 + 3]); pp.z = pk2(Sx[kb][8 * s2 + 4], Sx[kb][8 * s2 + 5]); pp.w = pk2(Sx[kb][8 * s2 + 6], Sx[kb][8 * s2 + 7]);
                const bf16x8 Pf = __builtin_bit_cast(bf16x8, pp);
#pragma unroll
                for (int db = 0; db < 2; ++db) { const LAS unsigned char* vp = vt + (db * 32 + n) * KV_STRIDE + (kb * 32 + 16 * s2 + 4 * hf) * 2;
                    const s16x4 lo = *(const LAS s16x4*)vp, hi = *(const LAS s16x4*)(vp + 16);
                    const bf16x8 Vf = __builtin_shufflevector(lo, hi, 0, 1, 2, 3, 4, 5, 6, 7);
                    O[db] = MFMA32(Vf, Pf, O[db]); } }
        asm volatile("" ::: "memory");
        KV_STORE();
        asm volatile("" ::: "memory");
    }
#undef KV_FETCH
#undef KV_STORE
    const float l = lrun + __shfl_xor(lrun, 32); const float inv = 1.f / l;
#pragma unroll
    for (int db = 0; db < 2; ++db)
#pragma unroll
        for (int g4 = 0; g4 < 4; ++g4) { const int d0 = db * 32 + 8 * g4 + 4 * hf; u32x2 o; o.x = pk2(O[db][4 * g4] * inv, O[db][4 * g4 + 1] * inv); o.y = pk2(O[db][4 * g4 + 2] * inv, O[db][4 * g4 + 3] * inv);
            *(u32x2*)(MIX + (size_t)mq * 2048 + h * 64 + d0) = o; }
}

DI void attn_sample_wave(const Params& p, LAS float* tbl, const int bh, const int lane) {
    unsigned char* ws = p.ws;
    const bf16_t* QK = (const bf16_t*)(ws + WS_QK); const bf16_t* VT = (const bf16_t*)(ws + WS_VT); bf16_t* MIX = (bf16_t*)(ws + WS_MIXIN);
    const bf16_t* KC = (const bf16_t*)(ws + WS_KC); const bf16_t* VTC = (const bf16_t*)(ws + WS_VTC);
    const int b = bh >> 4, h = bh & 15;
    for (int i = lane; i < 257; i += 64) tbl[i] = p.in[I_RB][h * 257 + i] * LOG2E;
    const int n = lane & 31, hf = lane >> 5, qi = n & 15;
    const int mq = MPR + b * 16 + qi;
    bf16x8 Qf[4];
#pragma unroll
    for (int s = 0; s < 4; ++s) Qf[s] = *(const bf16x8*)(QK + (size_t)mq * 2048 + h * 64 + 16 * s + 8 * hf);
    f32x16 O[2]; for (int i = 0; i < 16; ++i) { O[0][i] = 0.f; O[1][i] = 0.f; }
    float mrun = -1e30f, lrun = 0.f;
#pragma unroll 1
    for (int kc = 0; kc < 9; ++kc) {
        f32x16 Sx[2];
#pragma unroll
        for (int kb = 0; kb < 2; ++kb) { for (int i = 0; i < 16; ++i) Sx[kb][i] = 0.f;
            const bf16_t* kp = kc < 8 ? KC + ((size_t)(b * 512 + kc * 64 + kb * 32 + n) * 1024 + h * 64 + 8 * hf) : QK + (size_t)(MPR + b * 16 + qi) * 2048 + 1024 + h * 64 + 8 * hf;
#pragma unroll
            for (int s = 0; s < 4; ++s) Sx[kb] = MFMA32(*(const bf16x8*)(kp + 16 * s), Qf[s], Sx[kb]); }
        s16x4 Vlo[2][2][2], Vhi[2][2][2];
#pragma unroll
        for (int kb = 0; kb < 2; ++kb)
#pragma unroll
            for (int s2 = 0; s2 < 2; ++s2)
#pragma unroll
                for (int db = 0; db < 2; ++db) { const bf16_t* vp = kc < 8 ? VTC + ((size_t)(b * 1024 + h * 64 + db * 32 + n) * 512 + kc * 64 + kb * 32 + 16 * s2 + 4 * hf)
                                                                       : VT + (size_t)(h * 64 + db * 32 + n) * MPAD + MPR + b * 16 + kb * 32 + 16 * s2 + 4 * hf;
                    Vlo[kb][s2][db] = *(const s16x4*)vp; Vhi[kb][s2][db] = *(const s16x4*)(vp + 8); }
        float mx = -1e30f;
#pragma unroll
        for (int kb = 0; kb < 2; ++kb)
#pragma unroll
            for (int i = 0; i < 16; ++i) { const int j = kc * 64 + kb * 32 + crow(i, hf); int rel = 512 + qi - j; rel = rel < -128 ? -128 : (rel > 128 ? 128 : rel);
                float sv = Sx[kb][i] * LOG2E + tbl[rel + 128]; sv = j < 528 ? sv : -1e30f; Sx[kb][i] = sv; mx = fmaxf(mx, sv); }
        mx = fmaxf(mx, __shfl_xor(mx, 32));
        const float mnew = fmaxf(mrun, mx); const float alpha = __builtin_amdgcn_exp2f(mrun - mnew); mrun = mnew;
        float ls = 0.f;
#pragma unroll
        for (int kb = 0; kb < 2; ++kb)
#pragma unroll
            for (int i = 0; i < 16; ++i) { Sx[kb][i] = __builtin_amdgcn_exp2f(Sx[kb][i] - mnew); ls += Sx[kb][i]; }
        lrun = lrun * alpha + ls;
#pragma unroll
        for (int i = 0; i < 16; ++i) { O[0][i] *= alpha; O[1][i] *= alpha; }
#pragma unroll
        for (int kb = 0; kb < 2; ++kb)
#pragma unroll
            for (int s2 = 0; s2 < 2; ++s2) {
                u32x4 pp; pp.x = pk2(Sx[kb][8 * s2], Sx[kb][8 * s2 + 1]); pp.y = pk2(Sx[kb][8 * s2 + 2], Sx[kb][8 * s2 + 3]); pp.z = pk2(Sx[kb][8 * s2 + 4], Sx[kb][8 * s2 + 5]); pp.w = pk2(Sx[kb][8 * s2 + 6], Sx[kb][8 * s2 + 7]);
                const bf16x8 Pf = __builtin_bit_cast(bf16x8, pp);
#pragma unroll
                for (int db = 0; db < 2; ++db) { const bf16x8 Vf = __builtin_shufflevector(Vlo[kb][s2][db], Vhi[kb][s2][db], 0, 1, 2, 3, 4, 5, 6, 7);
                    O[db] = MFMA32(Vf, Pf, O[db]); } }
    }
    const float l = lrun + __shfl_xor(lrun, 32); const float inv = 1.f / l;
    if (n < 16) {
#pragma unroll
        for (int db = 0; db < 2; ++db)
#pragma unroll
            for (int g4 = 0; g4 < 4; ++g4) { const int d0 = db * 32 + 8 * g4 + 4 * hf; u32x2 o; o.x = pk2(O[db][4 * g4] * inv, O[db][4 * g4 + 1] * inv); o.y = pk2(O[db][4 * g4 + 2] * inv, O[db][4 * g4 + 3] * inv);
                *(u32x2*)(MIX + (size_t)mq * 2048 + h * 64 + d0) = o; } }
}

DI void attn_sample_task(const Params& p, LAS unsigned char* lds, int bt, const int tid_o) {
    const int tid = tid_o, wave = tid >> 6, lane = tid & 63;
    unsigned char* ws = p.ws;
    const bf16_t* QK = (const bf16_t*)(ws + WS_QK); const bf16_t* VT = (const bf16_t*)(ws + WS_VT); bf16_t* MIX = (bf16_t*)(ws + WS_MIXIN);
    const int b = bt >> 4, h = bt & 15;
    LAS float* qs = (LAS float*)lds;
    LAS float* sc = qs + 1024;
    LAS float* tbl = sc + 16 * 528;
    LAS float* rinv = tbl + 260;
    __syncthreads();
    for (int i = tid; i < 1024; i += 512) qs[i] = bf1(QK[(size_t)(MPR + b * 16 + (i >> 6)) * 2048 + h * 64 + (i & 63)]);
    for (int i = tid; i < 257; i += 512) tbl[i] = p.in[I_RB][h * 257 + i];
    __syncthreads();
    for (int j = tid; j < 528; j += 512) {
        float kv[64];
        if (j < 512) { const float* kp = p.in[I_CK] + (((size_t)b * 512 + j) * 16 + h) * 64;
#pragma unroll
            for (int d = 0; d < 16; ++d) { const f32x4 v = *(const f32x4*)(kp + 4 * d); kv[4 * d] = v.x; kv[4 * d + 1] = v.y; kv[4 * d + 2] = v.z; kv[4 * d + 3] = v.w; } }
        else { const bf16_t* kp = QK + (size_t)(MPR + b * 16 + (j - 512)) * 2048 + 1024 + h * 64;
#pragma unroll
            for (int d = 0; d < 8; ++d) unpack8(*(const u32x4*)(kp + 8 * d), kv + 8 * d); }
        for (int i = 0; i < 16; ++i) { float s = 0.f;
#pragma unroll
            for (int d = 0; d < 64; ++d) s += qs[i * 64 + d] * kv[d];
            int rel = 512 + i - j; rel = rel < -128 ? -128 : (rel > 128 ? 128 : rel);
            sc[i * 528 + j] = s + tbl[rel + 128]; }
    }
    __syncthreads();
    for (int i = wave * 2; i < wave * 2 + 2; ++i) { float mx = -1e30f;
        for (int j = lane; j < 528; j += 64) mx = fmaxf(mx, sc[i * 528 + j]);
#pragma unroll
        for (int o = 1; o < 64; o <<= 1) mx = fmaxf(mx, __shfl_xor(mx, o));
        float sum = 0.f;
        for (int j = lane; j < 528; j += 64) { const float e = __expf(sc[i * 528 + j] - mx); sc[i * 528 + j] = e; sum += e; }
        sum = wave_sum(sum);
        if (lane == 0) rinv[i] = 1.f / sum; }
    __syncthreads();
    {
        LAS float* red = rinv + 16;
        const int d = tid & 63, kg = tid >> 6; float acc[16];
#pragma unroll
        for (int i = 0; i < 16; ++i) acc[i] = 0.f;
        const float* vp = p.in[I_CV] + ((size_t)b * 512 * 16 + h) * 64 + d;
        const bf16_t* vt = VT + (size_t)(h * 64 + d) * MPAD + MPR + b * 16;
#pragma unroll 1
        for (int j0 = kg * 66; j0 < kg * 66 + 66; j0 += 11) { float v[11];
#pragma unroll
            for (int u = 0; u < 11; ++u) { const int j = j0 + u; const int jc = j < 512 ? j : 511; const float vc = vp[(size_t)jc * 1024]; const float vn = bf1(vt[j < 512 ? 0 : j - 512]); v[u] = j < 512 ? vc : vn; }
#pragma unroll
            for (int u = 0; u < 11; ++u)
#pragma unroll
                for (int i = 0; i < 16; ++i) acc[i] += sc[i * 528 + j0 + u] * v[u]; }
#pragma unroll
        for (int i = 0; i < 16; ++i) red[(kg * 16 + i) * 64 + d] = acc[i];
        __syncthreads();
        for (int o = tid; o < 1024; o += 512) { const int i = o >> 6, dd = o & 63; float sum = 0.f;
#pragma unroll
            for (int g = 0; g < 8; ++g) sum += red[(g * 16 + i) * 64 + dd];
            MIX[(size_t)(MPR + b * 16 + i) * 2048 + h * 64 + dd] = (bf16_t)(pk2(sum * rinv[i], 0.f) & 0xffffu); }
    }
}

DI void phase_mix(const Params& p, LAS unsigned char* lds, const int tid_o) {
    const int blk = blockIdx.x, G = gridDim.x;
    const int wave = __builtin_amdgcn_readfirstlane(tid_o >> 6), lane = tid_o & 63;
    __syncthreads();
    if (tid_o < 2 * SC_NB + 4) ((LAS unsigned*)(lds + L_FLAGS))[tid_o] = 0u;
    __syncthreads();
    if (wave <= 3) __builtin_amdgcn_s_setprio(3);
    if (wave <= 5) { scan_run(p, lds, wave, lane, blk, G);
        LAS unsigned* sdone = (LAS unsigned*)(lds + L_FLAGS) + 8;
        asm volatile("" ::: "memory");
        if (lane == 0) __hip_atomic_fetch_add(sdone, 1u, __ATOMIC_RELAXED, __HIP_MEMORY_SCOPE_WORKGROUP);
        if (wave <= 3) { while (__hip_atomic_load(sdone, __ATOMIC_RELAXED, __HIP_MEMORY_SCOPE_WORKGROUP) < 6u) __builtin_amdgcn_s_sleep(1); asm volatile("" ::: "memory"); } }
#if REPEAT_SUB == 1
    __syncthreads();
    if (tid_o < 2 * SC_NB) ((LAS unsigned*)(lds + L_FLAGS))[tid_o] = 0u;
    __syncthreads();
    if (wave <= 5) scan_run(p, lds, wave, lane, blk, G);
#endif
    __builtin_amdgcn_s_setprio(0);
    if (wave <= 3 || wave >= 6) {
        LAS float* tbl = (LAS float*)(lds + L_TBL + wave * 1040);
        LAS unsigned char* kv = wave >= 6 ? lds + L_KV + (wave - 6) * KV_BYTES : lds + wave * KV_BYTES;
        const unsigned myq = (unsigned)__builtin_amdgcn_s_getreg((3 << 11) | 20) & 7u;
        for (unsigned qo = 0; qo < 8u; ++qo) { const unsigned q = (myq + qo) & 7u; unsigned* ctr = (unsigned*)(p.ws + WS_CTR) + 128 + 16 * q;
            for (;;) { unsigned t = 0; if (lane == 0) t = atomicAdd(ctr, 1u); t = __builtin_amdgcn_readfirstlane(t); if (t >= 528u) break;
                if (t < 16u) attn_sample_wave(p, tbl, (int)(q + 8u * t), lane);
                else { const unsigned tp = t - 16u, rem = tp & 15u, bhp = q + 8u * (rem >> 1); const int task = (int)((tp >> 4) * 128u + (bhp >> 4) * 32u + (bhp & 15u) * 2u + (rem & 1u));
                    attn_wave_task(p, tbl, kv, task, lane); } } }
    }
}

DI void phase_post(const Params& p, const int tid_o) {
    const int tid = tid_o, wave = tid >> 6, lane = tid & 63, blk = blockIdx.x, G = gridDim.x;
    unsigned char* ws = p.ws;
    const float* Y = (const float*)(ws + WS_Y); const bf16_t* FV = (const bf16_t*)(ws + WS_FV); const bf16_t* GG = (const bf16_t*)(ws + WS_GG); const float* BON = (const float*)(ws + WS_BONUS);
    bf16_t* MIX = (bf16_t*)(ws + WS_MIXIN);
    const int gw = blk * 8 + wave, NGW = G * 8;
    for (int i = blk * 512 + tid; i < MS * DM / 4; i += G * 512) *(f32x4*)(p.out + (size_t)MPR * DM + (size_t)i * 4) = *(const f32x4*)(p.in[I_XS] + (size_t)i * 4);
    { float* out = p.out; const bf16_t* VT = (const bf16_t*)(ws + WS_VT);
    for (int task = gw; task < 16 * 34; task += NGW) { const int cb = task & 15, mc = task >> 4; const int c = cb * 64 + lane;
        const int mbase = mc < 32 ? ((mc >> 3) * SEQ + (SEQ - 512) + (mc & 7) * 64) : MPR + (mc - 32) * 64;
        float* ob = mc < 32 ? out + O_VP + ((size_t)(mc >> 3) * 512 + (mc & 7) * 64) * 1024 + c : out + O_VS + (size_t)((mc - 32) * 64) * 1024 + c;
        u32x4 raw[8];
#pragma unroll
        for (int j = 0; j < 8; ++j) raw[j] = *(const u32x4*)(VT + (size_t)c * MPAD + mbase + 8 * j);
#pragma unroll
        for (int j = 0; j < 8; ++j) { float f[8]; unpack8(raw[j], f);
#pragma unroll
            for (int e = 0; e < 8; ++e) ob[(size_t)(8 * j + e) * 1024] = f[e]; __builtin_amdgcn_sched_barrier(0); } }
    }
    for (int m = gw; m < MT; m += NGW) {
#pragma unroll
        for (int it = 0; it < 2; ++it) { const int c = it * 512 + lane * 8, h = c >> 6;
            const f32x4 y0 = __builtin_nontemporal_load((const f32x4*)(Y + (size_t)m * 1024 + c)), y1 = __builtin_nontemporal_load((const f32x4*)(Y + (size_t)m * 1024 + c + 4));
            float y[8] = {y0.x, y0.y, y0.z, y0.w, y1.x, y1.y, y1.z, y1.w};
            float s = 0.f;
#pragma unroll
            for (int j = 0; j < 8; ++j) s += y[j];
            s += __shfl_xor(s, 1); s += __shfl_xor(s, 2); s += __shfl_xor(s, 4);
            const float mu = s * (1.f / 64.f); float v2 = 0.f;
#pragma unroll
            for (int j = 0; j < 8; ++j) { y[j] -= mu; v2 += y[j] * y[j]; }
            v2 += __shfl_xor(v2, 1); v2 += __shfl_xor(v2, 2); v2 += __shfl_xor(v2, 4);
            const float rstd = rsqrtf(v2 * (1.f / 64.f) + 64e-5f);
            float vv[8], gg[8]; unpack8(__builtin_nontemporal_load((const u32x4*)(FV + (size_t)m * 1024 + c)), vv); unpack8(__builtin_nontemporal_load((const u32x4*)(GG + (size_t)m * 1024 + c)), gg);
            const float bon = BON[(size_t)m * 16 + h];
            const float* lw = p.in[I_LW] + c; const float* lb = p.in[I_LB] + c;
            float o[8];
#pragma unroll
            for (int j = 0; j < 8; ++j) { const float yn = y[j] * rstd * lw[j] + lb[j]; o[j] = (yn + bon * vv[j]) * gg[j]; }
            u32x4 q; q.x = pk2(o[0], o[1]); q.y = pk2(o[2], o[3]); q.z = pk2(o[4], o[5]); q.w = pk2(o[6], o[7]);
            *(u32x4*)(MIX + (size_t)m * 2048 + 1024 + c) = q; }
    }
}

DI void phase_act(const Params& p, const int tid_o) {
    const int tid = tid_o, blk = blockIdx.x, G = gridDim.x;
    unsigned char* ws = p.ws; float* out = p.out;
    bf16_t* GV = (bf16_t*)(ws + WS_GV);
    const float* cst = p.in[I_SC];
    for (int it = blk * 512 + tid; it < 130 * 704; it += G * 512) {
        const int f = (it % 704) * 8, strip = it / 704, m0 = strip * 64;
        float w0[8], w1[8], w2[8], bb[8];
#pragma unroll
        for (int j = 0; j < 8; ++j) { w0[j] = p.in[I_DWC][f + j]; w1[j] = p.in[I_DWC][DFF + f + j]; w2[j] = p.in[I_DWC][2 * DFF + f + j]; bb[j] = p.in[I_DWB][f + j]; }
        float p1[8], p2[8];
        for (int r0 = 0; r0 < 64; r0 += 4) {
            u32x4 craw[4], vraw[4];
#pragma unroll
            for (int rr = 0; rr < 4; ++rr) { craw[rr] = __builtin_nontemporal_load((const u32x4*)(GV + (size_t)(m0 + r0 + rr) * (2 * DFF) + f)); vraw[rr] = __builtin_nontemporal_load((const u32x4*)(GV + (size_t)(m0 + r0 + rr) * (2 * DFF) + DFF + f)); }
#pragma unroll
            for (int rr = 0; rr < 4; ++rr) { const int r = r0 + rr, m = m0 + r;
                int t, b; const bool samp = m >= MPR; if (samp) { t = (m - MPR) & 15; b = (m - MPR) >> 4; } else { t = m & (SEQ - 1); b = m >> 11; }
                if (r == 0 || t == 0) {
#pragma unroll
                    for (int off = 1; off <= 2; ++off) { float* d = off == 1 ? p1 : p2;
                        if (t - off >= 0) unpack8(*(const u32x4*)(GV + (size_t)(m - off) * (2 * DFF) + f), d);
                        else if (samp) { const float* sp = cst + ((size_t)b * 2 + (2 + t - off)) * DFF + f;
#pragma unroll
                            for (int j = 0; j < 8; ++j) d[j] = sp[j]; }
                        else {
#pragma unroll
                            for (int j = 0; j < 8; ++j) d[j] = 0.f; } } }
                float cur[8], val[8]; unpack8(craw[rr], cur); unpack8(vraw[rr], val);
                float o[8];
#pragma unroll
                for (int j = 0; j < 8; ++j) { const float cv = bb[j] + w0[j] * p2[j] + w1[j] * p1[j] + w2[j] * cur[j]; o[j] = gelu_f(cv) * val[j]; }
                u32x4 q; q.x = pk2(o[0], o[1]); q.y = pk2(o[2], o[3]); q.z = pk2(o[4], o[5]); q.w = pk2(o[6], o[7]);
                *(u32x4*)(GV + (size_t)m * (2 * DFF) + DFF + f) = q;
                const int tl = samp ? 14 : SEQ - 2;
                if (t >= tl) { float* op = out + (samp ? O_CVS : O_CVP) + ((size_t)b * 2 + (t - tl)) * DFF + f;
                    *(f32x4*)op = (f32x4){cur[0], cur[1], cur[2], cur[3]}; *(f32x4*)(op + 4) = (f32x4){cur[4], cur[5], cur[6], cur[7]}; }
#pragma unroll
                for (int j = 0; j < 8; ++j) { p2[j] = p1[j]; p1[j] = cur[j]; }
            }
        }
    }
}

#define XB_TMO      128
#define XB_XCNT(j)  (256  + 64 * (j))
#define XB_XSUB(j)  (1280 + 64 * (j))
#define XB_XGEN(j)  (2304 + 64 * (j))
#define XB_TOP      3328
#define XB_TOPGEN   3392
#define XCD_BAR_WORDS 3456
#define XB_SPIN_CAP (1u << 20)
DI unsigned xb_ld(unsigned* p)              { return __hip_atomic_load(p, __ATOMIC_RELAXED, __HIP_MEMORY_SCOPE_AGENT); }
DI unsigned xb_add(unsigned* p, unsigned v) { return __hip_atomic_fetch_add(p, v, __ATOMIC_RELAXED, __HIP_MEMORY_SCOPE_AGENT); }
DI unsigned xb_xcc_id() { return (unsigned)__builtin_amdgcn_s_getreg((3 << 11) | 20) & 0xFu; }
#define XB_SPIN(cond, bar) do { unsigned _sp = 0; while (cond) { __builtin_amdgcn_s_sleep(1); \
    if ((++_sp & 255u) == 0u) { if (xb_ld(&(bar)[XB_TMO])) break; if (_sp > XB_SPIN_CAP) { atomicAdd(&(bar)[XB_TMO], 1u); break; } } } } while (0)
DI void xcd_barrier_complete(unsigned* bar, unsigned x, unsigned& nloc, unsigned& nx) {
    const unsigned G = gridDim.x;
    unsigned sum, cnt, mine, sp = 0u;
    for (;;) {
        sum = 0u; cnt = 0u; mine = 0u;
#pragma unroll
        for (unsigned j = 0; j < 16; ++j) { const unsigned c = xb_ld(&bar[XB_XCNT(j)]); sum += c; cnt += (c > 0u) ? 1u : 0u; mine = (j == x) ? c : mine; }
        if (sum == G) break;
        __builtin_amdgcn_s_sleep(1);
        if ((++sp & 255u) == 0u) { if (xb_ld(&bar[XB_TMO])) break; if (sp > XB_SPIN_CAP) { atomicAdd(&bar[XB_TMO], 1u); break; } }
    }
    nloc = mine > 0u ? mine : 1u; nx = cnt > 0u ? cnt : 1u;
}
DI void xcd_barrier(unsigned* bar, const unsigned x, volatile LAS unsigned* st, const int tid_o) {
    asm volatile("s_waitcnt vmcnt(0)" ::: "memory");
    __syncthreads();
    if (tid_o == 0) {
        __builtin_amdgcn_s_waitcnt(0);
        unsigned nloc = st[0], nx = st[1];
        if (nloc == 0u) { xcd_barrier_complete(bar, x, nloc, nx); st[0] = nloc; st[1] = nx; }
        const unsigned old = xb_add(&bar[XB_XSUB(x)], 1u);
        const unsigned gen = old / nloc;
        if (old + 1u == (gen + 1u) * nloc) {
            __builtin_amdgcn_fence(__ATOMIC_RELEASE, "agent");
            asm volatile("s_waitcnt vmcnt(0)" ::: "memory");
            const unsigned og = xb_add(&bar[XB_TOP], 1u);
            const unsigned tg = og / nx;
            if (og + 1u == (tg + 1u) * nx) xb_add(&bar[XB_TOPGEN], 1u);
            else XB_SPIN(xb_ld(&bar[XB_TOPGEN]) == tg, bar);
            __builtin_amdgcn_fence(__ATOMIC_ACQUIRE, "agent");
            xb_add(&bar[XB_XGEN(x)], 1u);
            asm volatile("s_waitcnt vmcnt(0)" ::: "memory");
        } else {
            XB_SPIN(xb_ld(&bar[XB_XGEN(x)]) == gen, bar);
            __builtin_amdgcn_fence(__ATOMIC_ACQUIRE, "agent");
            asm volatile("s_waitcnt vmcnt(0)" ::: "memory");
        }
    }
    __syncthreads();
}

constexpr int NPHASE = 10;
__global__ void __launch_bounds__(512, 2) mega(Params p) {
    extern __shared__ __attribute__((aligned(16))) unsigned char shm[];
    LAS unsigned char* lds = (LAS unsigned char*)shm;
    cg::grid_group grid = cg::this_grid();
    unsigned char* ws = p.ws;
    const int G = gridDim.x, c = blockIdx.x;
#if PROG == 1
    constexpr int PROGRAM[] = {0, 1, 2, 3, 2, 3, 4, 5, 6, 7, 8, 9, 10};
#elif PROG == 2
    constexpr int PROGRAM[] = {0, 1, 2, 3, 4, 5, 6, 7, 8, 9, 8, 9, 10};
#elif PROG == 3
    constexpr int PROGRAM[] = {0, 1, 2, 3, 4, 5, 6, 7, 8, 9, 10, 5, 6, 10};
#elif PROG == 4
    constexpr int PROGRAM[] = {0, 1, 2, 3, 4, 5, 6, 5, 6, 7, 8, 9, 10};
#elif PROG == 5
    constexpr int PROGRAM[] = {0, 1, 2, 3, 4, 2, 3, 4, 5, 6, 7, 8, 9, 10};
#elif PROG == 7
    constexpr int PROGRAM[] = {0, 1, 2, 3, 4, 5, 6, 7, 8, 9, 11, 10};
#elif PROG == 8
    constexpr int PROGRAM[] = {0, 12, 12, 12, 12, 12, 12, 12, 12, 12, 12, 1, 2, 3, 4, 5, 6, 7, 8, 9, 10};
#elif PROG == 6
    constexpr int PROGRAM[] = {0, 0, 1, 1, 2, 3, 4, 5, 6, 7, 7, 8, 9, 10};
#else
    constexpr int PROGRAM[] = {0, 1, 2, 3, 4, 5, 6, 7, 8, 9, 10, 13};
#endif
    constexpr int NPROG = sizeof(PROGRAM) / sizeof(int);
    unsigned* xbar = (unsigned*)(ws + WS_BAR); const unsigned xcc = xb_xcc_id(); volatile LAS unsigned* xst = (volatile LAS unsigned*)(lds + 132864);
    if (threadIdx.x < 4) xst[threadIdx.x] = 0u;
    if (threadIdx.x == 0) (void)xb_add(&xbar[XB_XCNT(xcc)], 1u);
    __syncthreads();
    for (int pi = p.ph_lo; pi < p.ph_hi; ++pi) {
        int ph = 0;
#pragma unroll
        for (int q = 0; q < NPROG; ++q) if (q == pi) ph = PROGRAM[q];
        int tid_o = threadIdx.x; asm volatile("" : "+v"(tid_o));
        switch (ph) {
#ifndef ONLY
#define ONLY -1
#endif
#define PHON(x) (ONLY < 0 || ONLY == (x))
        case 0: if (PHON(0)) phase0(p, lds, tid_o); break;
        case 1: if (PHON(1)) phase_norm<0>(p, lds, tid_o); break;
        case 2: if (PHON(2)) { SchedIn S; S.H = (const char*)(ws + WS_H); S.W = (const char*)(ws + WS_WT_IN); S.G = G; S.c = c; S.base = 0; S.limit = G == 256 ? 768 : 825;
                  EpiIn E; E.QK = (bf16_t*)(ws + WS_QK); E.VT = (bf16_t*)(ws + WS_VT); E.ZR = (bf16_t*)(ws + WS_ZR);
                  pg8::gemm_phase(lds, pg8::GemmK{DM, DM, DM}, S, E, tid_o);
                  } break;
        case 3: if (PHON(3)) phase_prep(p, lds, tid_o); break;
        case 4: if (PHON(4)) phase_mix(p, lds, tid_o);
#if REPEAT_SUB == 4
            grid.sync(); if (blockIdx.x == 0 && tid_o < 64) ((unsigned*)(ws + WS_CTR))[tid_o] = 0u; grid.sync(); phase_mix(p, lds, tid_o);
#endif
            break;
        case 5: if (PHON(5)) phase_post(p, tid_o); break;
        case 6: if (PHON(6)) { SchedPlain S; S.A = (const char*)(ws + WS_MIXIN); S.B = (const char*)(ws + WS_WT_OUT); S.G = G; S.c = c; S.nM = 32; S.nN = 8; S.nfull = 256; S.ntK = DM / 64; S.total = 256 + 8 * 8; S.astep = (size_t)256 * DM * 2; S.bstep = (size_t)256 * DM * 2;
                  EpiRes<false> E; E.out = p.out; E.xp = p.in[I_XP]; E.xs = p.in[I_XS]; E.MOD = (const float*)(ws + WS_MOD); E.goff = 2 * DM; E.slab = (float*)(ws + WS_FV);
                  pg8::gemm_phase(lds, pg8::GemmK{DM, DM, DM}, S, E, tid_o); } break;
        case 7: if (PHON(7)) phase_norm<1>(p, lds, tid_o); break;
        case 8: if (PHON(8)) { SchedPlain S; S.A = (const char*)(ws + WS_H); S.B = (const char*)(ws + WS_WT_UP); S.G = G; S.c = c; S.nM = 33; S.nN = 44; S.nfull = 33 * 44; S.ntK = DM / 64; S.total = 33 * 44; S.astep = (size_t)256 * DM * 2; S.bstep = (size_t)256 * DM * 2;
                  EpiUp E; E.GV = (bf16_t*)(ws + WS_GV);
                  pg8::gemm_phase(lds, pg8::GemmK{DM, DM, DM}, S, E, tid_o); } break;
        case 9: if (PHON(9)) phase_act(p, tid_o); break;
#if PROG == 7
        case 11: { SchedPlain S; S.A = (const char*)(ws + WS_GV) + (size_t)DFF * 2; S.B = (const char*)(ws + WS_WT_DOWN); S.G = G; S.c = c; S.nM = 32; S.nN = 8; S.nfull = 256; S.ntK = DFF / 64; S.total = 256 + 8 * 22; S.astep = (size_t)256 * (2 * DFF) * 2; S.bstep = (size_t)256 * DFF * 2;
                  EpiNull E; E.sink = (float*)(ws + WS_CTR + 1024);
                  pg8::gemm_phase(lds, pg8::GemmK{DFF, 2 * DFF, DFF}, S, E, tid_o); } break;
#endif
        case 13: {
            const float* slab = (const float*)(ws + WS_FV); const float* MOD = (const float*)(ws + WS_MOD);
            for (int i = blockIdx.x * 512 + tid_o; i < MS * DM / 4; i += G * 512) { const int r = i >> 9, c4 = (i & 511) * 4; f32x4 sum = (f32x4){0.f, 0.f, 0.f, 0.f};
#pragma unroll
                for (int ks = 0; ks < 22; ++ks) sum += *(const f32x4*)(slab + ((size_t)ks * MS + r) * DM + c4);
                const f32x4 g = *(const f32x4*)(MOD + (size_t)(4 + (r >> 4)) * NMOD + 5 * DM + c4); f32x4* op = (f32x4*)(p.out + (size_t)(MPR + r) * DM + c4); *op = *op + g * sum; }
            } break;
        case 10: if (PHON(10)) { SchedPlain S; S.A = (const char*)(ws + WS_GV) + (size_t)DFF * 2; S.B = (const char*)(ws + WS_WT_DOWN); S.G = G; S.c = c; S.nM = 32; S.nN = 8; S.nfull = 256; S.ntK = DFF / 64; S.total = 256 + 8 * 22; S.astep = (size_t)256 * (2 * DFF) * 2; S.bstep = (size_t)256 * DFF * 2;
                  EpiRes<true> E; E.out = p.out; E.xp = nullptr; E.xs = nullptr; E.MOD = (const float*)(ws + WS_MOD); E.goff = 5 * DM; E.slab = (float*)(ws + WS_FV);
                  pg8::gemm_phase(lds, pg8::GemmK{DFF, 2 * DFF, DFF}, S, E, tid_o); } break;
        }
        if (pi + 1 < p.ph_hi) { if (p.ph_hi < 0) grid.sync(); xcd_barrier(xbar, xcc, xst, tid_o); }
    }
}

extern "C" void kernel_launch(void* const* d_in, const int* in_sizes, int n_in, void* d_out, int out_size, void* d_ws, size_t ws_size, hipStream_t stream) {
    constexpr size_t kDynLds = 133120;
    static int grid_blocks = 0;
    if (!grid_blocks) {
        int dev = 0, cus = 0, per_cu = 0;
        hipGetDevice(&dev);
        hipDeviceGetAttribute(&cus, hipDeviceAttributeMultiprocessorCount, dev);
        hipFuncSetAttribute((const void*)mega, hipFuncAttributeMaxDynamicSharedMemorySize, (int)kDynLds);
        hipOccupancyMaxActiveBlocksPerMultiprocessor(&per_cu, (const void*)mega, 512, kDynLds);
        if (per_cu < 1) per_cu = 1;
        grid_blocks = cus * per_cu;
        if (grid_blocks > 256) grid_blocks = 256;
    }
    Params p{};
    for (int i = 0; i < 33; ++i) p.in[i] = (const float*)d_in[i];
    p.out = (float*)d_out; p.ws = (unsigned char*)d_ws;
#if N_LAUNCH_PER_PHASE
    for (int ph = 0; ph < 11; ++ph) { p.ph_lo = ph; p.ph_hi = ph + 1; hipLaunchKernelGGL(mega, dim3(grid_blocks), dim3(512), kDynLds, stream, p); }
#else
    hipMemsetAsync((unsigned char*)d_ws + WS_BAR, 0, 16384, stream);
    p.ph_lo = 0; p.ph_hi = (PROG == 0) ? 12 : (PROG == 8 ? 21 : PROG == 7 ? 12 : ((PROG == 3 || PROG == 5 || PROG == 6) ? 14 : 13));
    void* args[] = {&p};
    hipError_t e = hipLaunchCooperativeKernel((const void*)mega, dim3(grid_blocks), dim3(512), args, kDynLds, stream);
    if (e != hipSuccess) fprintf(stderr, "cooperative launch failed: %s (grid %d)\n", hipGetErrorString(e), grid_blocks);
#endif
}
```

```cpp
#include <hip/hip_runtime.h>
#include <hip/hip_cooperative_groups.h>
#include <cstdio>
namespace cg = cooperative_groups;

#ifndef PROG
#define PROG 0
#endif
#ifndef REPEAT_SUB
#define REPEAT_SUB 0
#endif
#ifndef REPEAT_PHASE
#define REPEAT_PHASE -1
#endif
#ifndef N_LAUNCH_PER_PHASE
#define N_LAUNCH_PER_PHASE 0
#endif

#define DI __device__ __forceinline__
#define LAS __attribute__((address_space(3)))
typedef unsigned short bf16_t;
typedef short bf16x8 __attribute__((ext_vector_type(8)));
typedef short s16x4 __attribute__((ext_vector_type(4)));
typedef float f32x2 __attribute__((ext_vector_type(2)));
typedef float f32x4 __attribute__((ext_vector_type(4)));
typedef float f32x16 __attribute__((ext_vector_type(16)));
typedef unsigned u32x2 __attribute__((ext_vector_type(2)));
typedef unsigned u32x4 __attribute__((ext_vector_type(4)));
typedef __bf16 bf16x2_t __attribute__((ext_vector_type(2)));

constexpr int DM = 2048, SEQ = 2048, MPR = 8192, MS = 128, MT = 8320, MPAD = 8448;
constexpr int DIN = 6400, DSH = 3328, DFF = 5632, NMOD = 12288;
constexpr float LOG2E = 1.4426950408889634f;
enum { I_XP = 0, I_XS, I_CP, I_CS, I_CK, I_CV, I_SR, I_SS, I_SC, I_NAG, I_NFG, I_WADA, I_BADA, I_WIN, I_QG, I_KG, I_RB, I_MU, I_W0, I_W2, I_A0, I_A2, I_G2,
       I_KK, I_KA, I_RK, I_LW, I_LB, I_WOUT, I_WUP, I_DWC, I_DWB, I_WDN };
constexpr size_t O_Y = 0, O_KP = 17039360, O_VP = 19136512, O_SP = 21233664, O_SHP = 21495808, O_CVP = 21509120, O_KS = 21554176, O_VS = 21685248,
                 O_SS = 21816320, O_SHS = 22340608, O_CVS = 22367232;
constexpr size_t WS_WT_OUT = 0, WS_WT_UP = 8388608, WS_WT_DOWN = 54525952, WS_LT = 77594624, WS_MODP = 78118912, WS_MOD = 82837504, WS_BONUS = 83427328,
                 WS_CTR = 83959808, WS_BAR = 83963904, WS_R = 83963904 + 16384;
constexpr size_t WS_WT_IN = WS_R, WS_H = WS_R + 26214400, WS_MIXIN = WS_R, WS_GG = WS_R + 305004544  , WS_QK = WS_R + 60817408, WS_VT = WS_R + 95420416,
                 WS_ZR = WS_R + 112721920, WS_Y = WS_ZR, WS_FW = WS_R + 168951808, WS_FB = WS_R + 203030528, WS_FV = WS_R + 271187968, WS_GV = WS_QK, WS_KC = WS_R + 288227328, WS_VTC = WS_R + 288227328 + 8388608;

struct Params { const float* in[33]; float* out; unsigned char* ws; int ph_lo, ph_hi; };

DI unsigned pk2(float a, float b) { f32x2 v = {a, b}; bf16x2_t r = __builtin_convertvector(v, bf16x2_t); return __builtin_bit_cast(unsigned, r); }
DI float bflo(unsigned u) { return __uint_as_float(u << 16); }
DI float bfhi(unsigned u) { return __uint_as_float(u & 0xffff0000u); }
DI float bf1(bf16_t u) { return __uint_as_float(((unsigned)u) << 16); }
DI void unpack8(u32x4 v, float* f) { f[0] = bflo(v.x); f[1] = bfhi(v.x); f[2] = bflo(v.y); f[3] = bfhi(v.y); f[4] = bflo(v.z); f[5] = bfhi(v.z); f[6] = bflo(v.w); f[7] = bfhi(v.w); }
DI void unpack4(u32x2 v, float* f) { f[0] = bflo(v.x); f[1] = bfhi(v.x); f[2] = bflo(v.y); f[3] = bfhi(v.y); }
DI float wave_sum(float v) {
#pragma unroll
    for (int o = 1; o < 64; o <<= 1) v += __shfl_xor(v, o);
    return v;
}
DI float dpp_ror_add(float s, int) { return s; }
#define DPP_ADD(s, ctrl) ((s) + __builtin_bit_cast(float, __builtin_amdgcn_update_dpp(0, __builtin_bit_cast(int, (s)), (ctrl), 0xf, 0xf, false)))
DI float row16_sum(float s) { s = DPP_ADD(s, 0x128); s = DPP_ADD(s, 0x124); s = DPP_ADD(s, 0x122); s = DPP_ADD(s, 0x121); return s; }
DI int crow(int reg, int h) { return (reg & 3) + 8 * (reg >> 2) + 4 * h; }
DI float sigmoidf_(float x) { return 1.f / (1.f + __expf(-x)); }
#define MFMA32(a, b, c) __builtin_amdgcn_mfma_f32_32x32x16_bf16((a), (b), (c), 0, 0, 0)

DI float gelu_f(float v) {
    const float av = fabsf(v), d = av * 0.2316418882f + 1.0f;
    const float t = __builtin_amdgcn_rcpf(d);
    float q = t * 0.5307027145f + (-0.7265760135f); q = q * t + 0.7107068705f; q = q * t + (-0.142248368f); q = q * t + 0.127414796f; q = q * t;
    const float e = __builtin_amdgcn_exp2f((v * v) * (-0.72134752044f));
    const float m = v * (q * e), r = v - m;
    return v < 0.f ? m : r;
}

namespace pg8 {
constexpr int BM = 256, BK = 64, HALF = 128, HTB = HALF * BK * 2, STAGE_BYTES = 8 * HTB;
DI int lds_byte(int r, int c) { const int st = (r >> 4) * 2 + (c >> 5), rr = r & 15, cc = c & 31, ob = rr * 64 + cc * 2; return st * 1024 + (ob ^ (((ob >> 9) & 1) << 5)); }
DI void stage_rc(int b, int& R, int& C) { const int st = b / 1024, sb = b % 1024, swz = sb ^ (((sb >> 9) & 1) << 5); R = (st >> 1) * 16 + swz / 64; C = (st & 1) * 32 + (swz % 64) / 2; }
DI int perm32(int rho) { const int n = rho >> 4, i = rho & 15; return 8 * (i >> 2) + 4 * n + (i & 3); }
struct Unit { const char* a; const char* b; int kind, pm, pn, nt, ks; };
struct GemmK { int K, lda, ldb; };

template <class Epi, class Sched>
DI void gemm_phase(LAS unsigned char* lds, const GemmK g, const Sched& S, const Epi& E, const int tid_o) {
    const int tid = tid_o, wid = __builtin_amdgcn_readfirstlane(tid >> 6), lane = tid & 63, wr = wid >> 2, wc = wid & 3, fr = lane & 15, fq = lane >> 4;
    unsigned voffA[2], voffB[2];
#pragma unroll
    for (int i = 0; i < 2; ++i) { int R, C; stage_rc(tid * 16 + i * 8192, R, C); const int Rb = Epi::PERM ? ((R & ~31) + perm32(R & 31)) : R;
        voffA[i] = (unsigned)(R * g.lda + C) * 2u; voffB[i] = (unsigned)(Rb * g.ldb + C) * 2u; }
    const size_t kstep = (size_t)(BK * 2);
    const size_t hstepA = (size_t)HALF * g.lda * 2, hstepB = (size_t)HALF * g.ldb * 2;
    const unsigned ldsw = (unsigned)wid * 1024u;
    const int aoff = lds_byte(wr * 64 + fr, fq * 8), boff = lds_byte(wc * 32 + fr, fq * 8);
#define PG8_SA(b, h) (((b) * 2 + (h)) * HTB)
#define PG8_SB(b, h) ((4 + (b) * 2 + (h)) * HTB)
#define PG8_STAGE(bufoff, gbase, voff) do { _Pragma("unroll") for (int _i = 0; _i < 2; ++_i) \
        __builtin_amdgcn_global_load_lds((const unsigned*)((const char*)(gbase) + (voff)[_i]), (LAS unsigned*)(lds + (bufoff) + ldsw + _i * 8192), 16, 0, 0); } while (0)
#define PG8_LDA(dst, b, h) do { _Pragma("unroll") for (int m = 0; m < 4; ++m) _Pragma("unroll") for (int k = 0; k < 2; ++k) dst[m][k] = *(const LAS bf16x8*)(lds + PG8_SA(b, h) + aoff + m * 2048 + k * 1024); } while (0)
#define PG8_LDB(dst, b, h) do { _Pragma("unroll") for (int n = 0; n < 2; ++n) _Pragma("unroll") for (int k = 0; k < 2; ++k) dst[n][k] = *(const LAS bf16x8*)(lds + PG8_SB(b, h) + boff + n * 2048 + k * 1024); } while (0)
#define PG8_MMA(ai, bj, At, Bt) do { __builtin_amdgcn_s_setprio(1); _Pragma("unroll") for (int m = 0; m < 4; ++m) _Pragma("unroll") for (int n = 0; n < 2; ++n) _Pragma("unroll") for (int k = 0; k < 2; ++k) \
        acc[ai][bj][m][n] = __builtin_amdgcn_mfma_f32_16x16x32_bf16(Bt[n][k], At[m][k], acc[ai][bj][m][n], 0, 0, 0); __builtin_amdgcn_s_setprio(0); } while (0)
#define PG8_WAIT_V(n) asm volatile("s_waitcnt vmcnt(" #n ")" ::: "memory")
#define PG8_WAIT_L(n) asm volatile("s_waitcnt lgkmcnt(" #n ")" ::: "memory")
#define PG8_BAR __builtin_amdgcn_s_barrier()
#define PG8_SCHED __builtin_amdgcn_sched_barrier(0)
    Unit cur, nxt; int ui = 0;
    if (!S.next(0, cur)) return;
    f32x4 acc[2][2][4][2];
#pragma unroll
    for (int a = 0; a < 2; ++a)
#pragma unroll
        for (int b = 0; b < 2; ++b)
#pragma unroll
            for (int m = 0; m < 4; ++m)
#pragma unroll
                for (int n = 0; n < 2; ++n) acc[a][b][m][n] = (f32x4){0.f, 0.f, 0.f, 0.f};
    bf16x8 At[4][2], B0[2][2], B1[2][2];
    const char* cA = cur.a; const char* cB = cur.b;
    PG8_STAGE(PG8_SB(0, 0), cB, voffB); PG8_STAGE(PG8_SA(0, 0), cA, voffA); PG8_STAGE(PG8_SB(0, 1), cB + hstepB, voffB); PG8_STAGE(PG8_SA(0, 1), cA + hstepA, voffA);
    if (wr == 1) PG8_BAR;
    PG8_WAIT_V(4); PG8_BAR;
    PG8_STAGE(PG8_SB(1, 0), cB + kstep, voffB); PG8_STAGE(PG8_SA(1, 0), cA + kstep, voffA); PG8_STAGE(PG8_SB(1, 1), cB + hstepB + kstep, voffB);
    PG8_WAIT_V(6); PG8_BAR;
    for (;;) {
        const bool has_next = S.next(ui + 1, nxt);
        const char* nA = has_next ? nxt.a : cA; const char* nB = has_next ? nxt.b : cB;
        const int nt = cur.nt;
        for (int t = 0; t < nt; t += 2) {
            const bool last = (t == nt - 2);
            const char* a1 = cA + (size_t)(t + 1) * kstep;
            const char* a2 = last ? nA : cA + (size_t)(t + 2) * kstep; const char* b2 = last ? nB : cB + (size_t)(t + 2) * kstep;
            const char* a3 = a2 + kstep; const char* b3 = b2 + kstep;
            PG8_LDB(B0, 0, 0); PG8_SCHED; PG8_LDA(At, 0, 0); PG8_STAGE(PG8_SA(1, 1), a1 + hstepA, voffA);
            PG8_WAIT_L(8); PG8_BAR; PG8_WAIT_L(0); PG8_MMA(0, 0, At, B0); PG8_BAR; PG8_SCHED;
            PG8_LDB(B1, 0, 1); PG8_STAGE(PG8_SB(0, 0), b2, voffB);
            PG8_BAR; PG8_WAIT_L(0); PG8_MMA(0, 1, At, B1); PG8_BAR;
            PG8_LDA(At, 0, 1); PG8_STAGE(PG8_SA(0, 0), a2, voffA);
            PG8_BAR; PG8_WAIT_L(0); PG8_MMA(1, 0, At, B0); PG8_BAR; PG8_SCHED;
            PG8_STAGE(PG8_SB(0, 1), b2 + hstepB, voffB);
            PG8_WAIT_V(6); PG8_BAR; PG8_MMA(1, 1, At, B1); PG8_BAR;
            PG8_LDB(B0, 1, 0); PG8_SCHED; PG8_LDA(At, 1, 0); PG8_STAGE(PG8_SA(0, 1), a2 + hstepA, voffA);
            PG8_WAIT_L(8); PG8_BAR; PG8_WAIT_L(0); PG8_MMA(0, 0, At, B0); PG8_BAR; PG8_SCHED;
            PG8_LDB(B1, 1, 1); PG8_STAGE(PG8_SB(1, 0), b3, voffB);
            PG8_BAR; PG8_WAIT_L(0); PG8_MMA(0, 1, At, B1); PG8_BAR;
            PG8_LDA(At, 1, 1); PG8_STAGE(PG8_SA(1, 0), a3, voffA);
            PG8_BAR; PG8_WAIT_L(0); PG8_MMA(1, 0, At, B0); PG8_BAR; PG8_SCHED;
            PG8_STAGE(PG8_SB(1, 1), b3 + hstepB, voffB);
            PG8_WAIT_V(6); PG8_BAR; PG8_MMA(1, 1, At, B1); PG8_BAR;
        }
        E(acc, cur, wr, wc, fr, fq);
        if (!has_next) break;
#pragma unroll
        for (int a = 0; a < 2; ++a)
#pragma unroll
            for (int b = 0; b < 2; ++b)
#pragma unroll
                for (int m = 0; m < 4; ++m)
#pragma unroll
                    for (int n = 0; n < 2; ++n) acc[a][b][m][n] = (f32x4){0.f, 0.f, 0.f, 0.f};
        cur = nxt; cA = nA; cB = nB; ++ui;
    }
    PG8_WAIT_V(0);
    if (wr == 0) PG8_BAR;
    PG8_BAR;
#undef PG8_SA
#undef PG8_SB
#undef PG8_STAGE
#undef PG8_LDA
#undef PG8_LDB
#undef PG8_MMA
#undef PG8_WAIT_V
#undef PG8_WAIT_L
#undef PG8_BAR
#undef PG8_SCHED
}
}
using pg8::Unit;

DI int unit_index(int i, int G, int c) { return G == 256 ? ((i * 8 + (c & 7)) * 32 + (c >> 3)) : (i * G + c); }
DI void band_decode(int U, int nM, int nN, int& pm, int& pn) { const int band = U / (4 * nN), rem = U - band * 4 * nN; const int rows = (nM - 4 * band) < 4 ? (nM - 4 * band) : 4; pn = rem / rows; pm = 4 * band + (rem - pn * rows); }
struct SchedIn {
    const char* H; const char* W; int G, c, base, limit;
    DI bool next(int i, Unit& u) const {
        const int L = base + unit_index(i, G, c); if (L >= limit) return false;
        if (L < 693) { int pm, j; band_decode(L, 33, 21, pm, j); const int pn = j < 8 ? j : j + 4; u.kind = 0; u.nt = DM / 64; u.pm = pm; u.pn = pn; u.a = H + (size_t)pm * 256 * DM * 2; u.b = W + (size_t)pn * 256 * DM * 2; }
        else { const int r = L - 693, i4 = r & 3, j = r >> 2; u.kind = 1; u.nt = DM / 64; u.pm = i4; u.pn = j; u.a = W + (size_t)(2048 + 256 * i4) * DM * 2; u.b = H + (size_t)j * 256 * DM * 2; }
        return true;
    }
};
struct SchedPlain { const char* A; const char* B; int G, c, nM, nN, total, ntK, nfull; size_t astep, bstep;
    DI bool next(int i, Unit& u) const {
        const int L = unit_index(i, G, c); if (L >= total) return false;
        if (L < nfull) { int pm, pn; band_decode(L, nM, nN, pm, pn); u.kind = 0; u.nt = ntK; u.pm = pm; u.pn = pn; u.a = A + (size_t)pm * astep; u.b = B + (size_t)pn * bstep; }
        else { const int s = L - nfull, pn = s % nN, ks = s / nN; u.kind = 2; u.nt = 4; u.pm = 32; u.pn = pn; u.ks = ks; u.a = A + (size_t)32 * astep + (size_t)ks * 512; u.b = B + (size_t)pn * bstep + (size_t)ks * 512; }
        return true;
    }
};
struct EpiIn { static constexpr bool PERM = true; bf16_t* QK; bf16_t* VT; bf16_t* ZR;
    DI void operator()(const f32x4 (&acc)[2][2][4][2], const Unit& u, int wr, int wc, int fr, int fq) const {
        bf16_t* base; int ldc, colt; const int rowt = u.pm * 256;
        if (u.kind == 0) { if (u.pn < 8) { base = QK; ldc = 2048; colt = u.pn * 256; } else { base = ZR; ldc = DSH; colt = (u.pn - 12) * 256; } }
        else { base = VT; ldc = MPAD; colt = u.pn * 256; }
        const int row0 = rowt + wr * 64 + fr, col0 = colt + wc * 32 + 8 * fq;
#pragma unroll
        for (int ai = 0; ai < 2; ++ai)
#pragma unroll
            for (int m = 0; m < 4; ++m) { bf16_t* rowp = base + (size_t)(row0 + ai * 128 + m * 16) * ldc + col0;
#pragma unroll
                for (int bj = 0; bj < 2; ++bj) { const f32x4 v0 = acc[ai][bj][m][0], v1 = acc[ai][bj][m][1];
                    u32x4 o; o.x = pk2(v0[0], v0[1]); o.y = pk2(v0[2], v0[3]); o.z = pk2(v1[0], v1[1]); o.w = pk2(v1[2], v1[3]);
                    *(u32x4*)(rowp + bj * 128) = o; } }
    }
};
struct EpiUp { static constexpr bool PERM = true; bf16_t* GV;
    DI void operator()(const f32x4 (&acc)[2][2][4][2], const Unit& u, int wr, int wc, int fr, int fq) const {
        const int row0 = u.pm * 256 + wr * 64 + fr, col0 = u.pn * 256 + wc * 32 + 8 * fq;
#pragma unroll
        for (int ai = 0; ai < 2; ++ai)
#pragma unroll
            for (int m = 0; m < 4; ++m) { bf16_t* rowp = GV + (size_t)(row0 + ai * 128 + m * 16) * (2 * DFF) + col0;
#pragma unroll
                for (int bj = 0; bj < 2; ++bj) { const f32x4 v0 = acc[ai][bj][m][0], v1 = acc[ai][bj][m][1];
                    u32x4 o; o.x = pk2(v0[0], v0[1]); o.y = pk2(v0[2], v0[3]); o.z = pk2(v1[0], v1[1]); o.w = pk2(v1[2], v1[3]);
                    *(u32x4*)(rowp + bj * 128) = o; } }
    }
};
struct EpiNull { static constexpr bool PERM = false; float* sink;
    DI void operator()(const f32x4 (&acc)[2][2][4][2], const Unit& u, int wr, int wc, int fr, int fq) const { if (acc[0][0][0][0][0] == 123456.789f) sink[0] = 1.f; }
};
template <bool RMW> struct EpiRes { static constexpr bool PERM = false; float* out; const float* xp; const float* xs; const float* MOD; int goff; float* slab;
    DI void operator()(const f32x4 (&acc)[2][2][4][2], const Unit& u, int wr, int wc, int fr, int fq) const {
        const int row0 = u.pm * 256 + wr * 64 + fr, col0 = u.pn * 256 + wc * 32 + 4 * fq;
#pragma unroll
        for (int ai = 0; ai < 2; ++ai)
#pragma unroll
            for (int m = 0; m < 4; ++m) { const int row = row0 + ai * 128 + m * 16;
                if (row < MT) {
                    const int b = row < MPR ? (row >> 11) : 4 + ((row - MPR) >> 4);
                    const float* gp = MOD + (size_t)b * NMOD + goff + col0;
                    float* op = out + (size_t)row * DM + col0;
                    const float* xr = RMW ? op : (row < MPR ? xp + (size_t)row * DM + col0 : xs + (size_t)(row - MPR) * DM + col0);
#pragma unroll
                    for (int bj = 0; bj < 2; ++bj)
#pragma unroll
                        for (int n = 0; n < 2; ++n) { const int o = bj * 128 + n * 16;
                            const f32x4 gv = *(const f32x4*)(gp + o); const f32x4 xv = __builtin_nontemporal_load((const f32x4*)(xr + o));
                            if (u.kind == 2) *(f32x4*)(slab + ((size_t)u.ks * MS + (row - MPR)) * DM + col0 + o) = acc[ai][bj][m][n];
                            else if (RMW) __builtin_nontemporal_store(xv + gv * acc[ai][bj][m][n], (f32x4*)(op + o));
                            else *(f32x4*)(op + o) = xv + gv * acc[ai][bj][m][n]; } } }
    }
};

DI void transpose_item(const float* W, int N, bf16_t* WT, int ldt, int coloff, LAS float* scr, int item, int lane) {
    const int nblk = N / 32, kb = item / nblk, nb = item % nblk, k0 = 64 * kb, n0 = 32 * nb;
#pragma unroll 8
    for (int i = 0; i < 32; ++i) { const int kk = 2 * i + (lane >> 5); scr[kk * 33 + (lane & 31)] = __builtin_nontemporal_load(W + (size_t)(k0 + kk) * N + n0 + (lane & 31)); }
    asm volatile("s_waitcnt lgkmcnt(0)" ::: "memory");
    const int c = lane & 7;
#pragma unroll
    for (int j = 0; j < 4; ++j) { const int n = (lane >> 3) + 8 * j; const LAS float* s = scr + (8 * c) * 33 + n;
        u32x4 o; o.x = pk2(s[0 * 33], s[1 * 33]); o.y = pk2(s[2 * 33], s[3 * 33]); o.z = pk2(s[4 * 33], s[5 * 33]); o.w = pk2(s[6 * 33], s[7 * 33]);
        *(u32x4*)(WT + (size_t)(n0 + n) * ldt + coloff + k0 + 8 * c) = o; }
    asm volatile("s_waitcnt lgkmcnt(0)" ::: "memory");
}
DI void phase0(const Params& p, LAS unsigned char* lds, const int tid_o) {
    const int tid = tid_o, wave = tid >> 6, lane = tid & 63, blk = blockIdx.x, G = gridDim.x;
    unsigned char* ws = p.ws;
    if (blk == 0 && tid < 64) ((unsigned*)(ws + WS_CTR))[64 + tid] = 0u;
    LAS float* sc = (LAS float*)lds;
    LAS float* red = (LAS float*)(lds + 12288);
    float* MODP = (float*)(ws + WS_MODP);
    const float* w_ada = p.in[I_WADA];
    for (int tile = blk; tile < 384; tile += G) {
        const int ct = tile % 48, kc = tile / 48;
        __syncthreads();
        for (int i = tid; i < 3072; i += 512) { const int r = i >> 8, kk = i & 255;
            const float cv = r < 4 ? p.in[I_CP][r * DM + kc * 256 + kk] : p.in[I_CS][(r - 4) * DM + kc * 256 + kk];
            sc[i] = cv / (1.f + __expf(-cv)); }
        __syncthreads();
        f32x4 acc[12];
#pragma unroll
        for (int r = 0; r < 12; ++r) acc[r] = (f32x4){0.f, 0.f, 0.f, 0.f};
        const float* wp = w_ada + (size_t)(kc * 256 + wave * 32) * NMOD + ct * 256 + lane * 4;
#pragma unroll 4
        for (int k = 0; k < 32; ++k) { const f32x4 wv = __builtin_nontemporal_load((const f32x4*)(wp + (size_t)k * NMOD));
#pragma unroll
            for (int r = 0; r < 12; ++r) acc[r] += sc[r * 256 + wave * 32 + k] * wv; }
#pragma unroll
        for (int r = 0; r < 12; ++r) *(LAS f32x4*)(red + (wave * 12 + r) * 256 + lane * 4) = acc[r];
        __syncthreads();
        for (int i = tid; i < 3072; i += 512) { const int r = i >> 8, cc = i & 255; float s = 0.f;
#pragma unroll
            for (int w = 0; w < 8; ++w) s += red[(w * 12 + r) * 256 + cc];
            MODP[(size_t)(kc * 12 + r) * NMOD + ct * 256 + cc] = s; }
    }
    __syncthreads();
    LAS float* scr = (LAS float*)(lds + wave * 16384);
    const int gw = blk * 8 + wave, NGW = G * 8;
    constexpr int I_IN = 32 * 200, I_OUT = 32 * 64, I_UP = 32 * 352, I_DN = 88 * 64, I_L = 32;
    constexpr int NITEMS = I_IN + I_OUT + I_UP + I_DN + 4 * I_L;
    for (int it = gw; it < NITEMS; it += NGW) {
        int r = it;
        if (r < I_IN) { transpose_item(p.in[I_WIN], DIN, (bf16_t*)(ws + WS_WT_IN), DM, 0, scr, r, lane); continue; } r -= I_IN;
        if (r < I_OUT) { transpose_item(p.in[I_WOUT], DM, (bf16_t*)(ws + WS_WT_OUT), DM, 0, scr, r, lane); continue; } r -= I_OUT;
        if (r < I_UP) { transpose_item(p.in[I_WUP], 2 * DFF, (bf16_t*)(ws + WS_WT_UP), DM, 0, scr, r, lane); continue; } r -= I_UP;
        if (r < I_DN) { transpose_item(p.in[I_WDN], DM, (bf16_t*)(ws + WS_WT_DOWN), DFF, 0, scr, r, lane); continue; } r -= I_DN;
        if (r < I_L) { transpose_item(p.in[I_W2], 1024, (bf16_t*)(ws + WS_LT), 256, 0, scr, r, lane); continue; } r -= I_L;
        if (r < I_L) { transpose_item(p.in[I_A2], 1024, (bf16_t*)(ws + WS_LT), 256, 64, scr, r, lane); continue; } r -= I_L;
        transpose_item(p.in[I_G2], 1024, (bf16_t*)(ws + WS_LT), 256, 128, scr, r, lane);
    }
}

DI void deferred_convert(const Params& p, LAS unsigned char* lds, const int tid_o) {
    const int wave = __builtin_amdgcn_readfirstlane(tid_o >> 6), lane = tid_o & 63;
    unsigned char* ws = p.ws; unsigned* ctr = (unsigned*)(ws + WS_CTR) + 64;
    LAS float* scr = (LAS float*)(lds + wave * 16384);
    constexpr int I_OUT = 32 * 64, I_UP = 32 * 352, I_DN = 88 * 64;
    for (;;) { unsigned t = 0; if (lane == 0) t = atomicAdd(ctr, 1u); int r = (int)__builtin_amdgcn_readfirstlane(t); if (r >= I_OUT + I_UP + I_DN) break;
        if (r < I_OUT) { transpose_item(p.in[I_WOUT], DM, (bf16_t*)(ws + WS_WT_OUT), DM, 0, scr, r, lane); continue; } r -= I_OUT;
        if (r < I_UP) { transpose_item(p.in[I_WUP], 2 * DFF, (bf16_t*)(ws + WS_WT_UP), DM, 0, scr, r, lane); continue; } r -= I_UP;
        transpose_item(p.in[I_WDN], DM, (bf16_t*)(ws + WS_WT_DOWN), DFF, 0, scr, r, lane); }
}

template <int WHICH> DI void phase_norm(const Params& p, LAS unsigned char* lds, const int tid_o) {
    const int tid = tid_o, wave = tid >> 6, lane = tid & 63, blk = blockIdx.x, G = gridDim.x;
    unsigned char* ws = p.ws;
    const float* MODP = (const float*)(ws + WS_MODP); float* MOD = (float*)(ws + WS_MOD);
    const float* b_ada = p.in[I_BADA];
    if (WHICH == 0) {
        for (int r = blk; r < 12; r += G)
            for (int j = tid; j < NMOD; j += 512) { float s = b_ada[j];
#pragma unroll
                for (int pp = 0; pp < 8; ++pp) s += MODP[(size_t)(pp * 12 + r) * NMOD + j];
                MOD[(size_t)r * NMOD + j] = s; }
    }
    LAS float* Al = (LAS float*)lds; LAS float* Bl = Al + DM;
    const float* gamma = WHICH == 0 ? p.in[I_NAG] : p.in[I_NFG];
    bf16_t* H = (bf16_t*)(ws + WS_H);
    for (int chunk = blk; chunk < 264; chunk += G) {
        const int b = chunk < 256 ? (chunk >> 6) : 4 + (chunk - 256);
        __syncthreads();
        for (int j = tid; j < DM; j += 512) { float scv, shv;
            if (WHICH == 0) { scv = b_ada[DM + j]; shv = b_ada[j];
#pragma unroll
                for (int pp = 0; pp < 8; ++pp) { scv += MODP[(size_t)(pp * 12 + b) * NMOD + DM + j]; shv += MODP[(size_t)(pp * 12 + b) * NMOD + j]; } }
            else { scv = MOD[(size_t)b * NMOD + 4 * DM + j]; shv = MOD[(size_t)b * NMOD + 3 * DM + j]; }
            Al[j] = gamma[j] * (1.f + scv); Bl[j] = shv; }
        __syncthreads();
        const int nrows = chunk < 256 ? 32 : 16, row0 = chunk < 256 ? chunk * 32 : MPR + (chunk - 256) * 16;
        if (WHICH == 1 && chunk >= 256) {
            const float* slab = (const float*)(ws + WS_FV);
            for (int i = tid; i < 16 * DM / 4; i += 512) { const int r = i >> 9, c4 = (i & 511) * 4; const int m = row0 + r; f32x4 sum = (f32x4){0.f, 0.f, 0.f, 0.f};
#pragma unroll
                for (int ks = 0; ks < 8; ++ks) sum += *(const f32x4*)(slab + ((size_t)ks * MS + (m - MPR)) * DM + c4);
                const f32x4 g = *(const f32x4*)(MOD + (size_t)b * NMOD + 2 * DM + c4); f32x4* op = (f32x4*)(p.out + (size_t)m * DM + c4); *op = *op + g * sum; }
            __syncthreads();
        }
        const int nr = nrows >> 3;
        for (int rp = 0; rp < nr; rp += 2) {
            f32x4 v[2][8]; float ss[2] = {0.f, 0.f};
#pragma unroll
            for (int q = 0; q < 2; ++q) { const int m = row0 + wave + 8 * (rp + q);
                const float* xr = WHICH == 0 ? (m < MPR ? p.in[I_XP] + (size_t)m * DM : p.in[I_XS] + (size_t)(m - MPR) * DM) : p.out + (size_t)m * DM;
#pragma unroll
                for (int j = 0; j < 8; ++j) v[q][j] = __builtin_nontemporal_load((const f32x4*)(xr + j * 256 + lane * 4)); }
#pragma unroll
            for (int q = 0; q < 2; ++q) {
#pragma unroll
                for (int j = 0; j < 8; ++j) ss[q] += v[q][j].x * v[q][j].x + v[q][j].y * v[q][j].y + v[q][j].z * v[q][j].z + v[q][j].w * v[q][j].w; }
#pragma unroll
            for (int q = 0; q < 2; ++q) { const int m = row0 + wave + 8 * (rp + q);
                const float rstd = rsqrtf(wave_sum(ss[q]) * (1.f / DM) + 1e-6f);
#pragma unroll
                for (int j = 0; j < 8; ++j) { const int idx = j * 256 + lane * 4; const f32x4 a4 = *(const LAS f32x4*)(Al + idx), b4 = *(const LAS f32x4*)(Bl + idx);
                    const f32x4 o = v[q][j] * rstd * a4 + b4; u32x2 qq; qq.x = pk2(o.x, o.y); qq.y = pk2(o.z, o.w);
                    *(u32x2*)(H + (size_t)m * DM + idx) = qq; } }
        }
    }
}

DI void load_zs(const Params& p, const bf16_t* ZR, int m, int c, int n, float* o) {
    const bool samp = m >= MPR; const int t = samp ? ((m - MPR) & 15) : (m & (SEQ - 1)); const int bs = samp ? ((m - MPR) >> 4) : 0;
    const int mp = t > 0 ? m - 1 : m;
    float z[8], zp[8], st[8];
    if (n == 8) { unpack8(*(const u32x4*)(ZR + (size_t)m * DSH + c), z); unpack8(*(const u32x4*)(ZR + (size_t)mp * DSH + c), zp);
        const f32x4 s0 = *(const f32x4*)(p.in[I_SS] + (size_t)bs * DSH + c), s1 = *(const f32x4*)(p.in[I_SS] + (size_t)bs * DSH + c + 4);
        st[0] = s0.x; st[1] = s0.y; st[2] = s0.z; st[3] = s0.w; st[4] = s1.x; st[5] = s1.y; st[6] = s1.z; st[7] = s1.w; }
    else { unpack4(*(const u32x2*)(ZR + (size_t)m * DSH + c), z); unpack4(*(const u32x2*)(ZR + (size_t)mp * DSH + c), zp);
        const f32x4 s0 = *(const f32x4*)(p.in[I_SS] + (size_t)bs * DSH + c); st[0] = s0.x; st[1] = s0.y; st[2] = s0.z; st[3] = s0.w; }
    const float* mu = p.in[I_MU] + c;
#pragma unroll
    for (int j = 0; j < n; ++j) { const float pv = t > 0 ? zp[j] : (samp ? st[j] : 0.f); o[j] = z[j] + (pv - z[j]) * mu[j]; }
}
DI void phase_prep(const Params& p, LAS unsigned char* lds, const int tid_o) {
    const int tid = tid_o, wave = tid >> 6, lane = tid & 63, blk = blockIdx.x, G = gridDim.x;
    unsigned char* ws = p.ws; float* out = p.out;
    bf16_t* QK = (bf16_t*)(ws + WS_QK); const bf16_t* VT = (const bf16_t*)(ws + WS_VT); const bf16_t* ZR = (const bf16_t*)(ws + WS_ZR);
    const int gw = blk * 8 + wave, NGW = G * 8;
    if (blk == 0 && tid >= 128 && tid < 256) ((unsigned*)(ws + WS_CTR))[tid] = 0u;
    if (G == 256) {
        SchedIn S; S.H = (const char*)(ws + WS_H); S.W = (const char*)(ws + WS_WT_IN); S.G = G; S.c = blk; S.base = 768; S.limit = 825;
        EpiIn E; E.QK = (bf16_t*)(ws + WS_QK); E.VT = (bf16_t*)(ws + WS_VT); E.ZR = (bf16_t*)(ws + WS_ZR);
        pg8::gemm_phase(lds, pg8::GemmK{DM, DM, DM}, S, E, tid_o);
        __syncthreads();
    }
    for (int m = gw; m < MT; m += NGW) {
        int lane_o = lane; asm volatile("" : "+v"(lane_o));
#pragma unroll
        for (int it = 0; it < 4; ++it) { const int col = it * 512 + lane_o * 8;
            float x[8]; unpack8(*(const u32x4*)(QK + (size_t)m * 2048 + col), x);
            float ss = 0.f;
#pragma unroll
            for (int j = 0; j < 8; ++j) ss += x[j] * x[j];
            ss += __shfl_xor(ss, 1); ss += __shfl_xor(ss, 2); ss += __shfl_xor(ss, 4);
            const float rstd = rsqrtf(ss * (1.f / 64.f) + 1e-6f);
            const bool isk = col >= 1024; const float* g = (isk ? p.in[I_KG] : p.in[I_QG]) + (col & 63);
            float y[8];
#pragma unroll
            for (int j = 0; j < 8; ++j) y[j] = x[j] * rstd * g[j];
            if (isk) {
                const int hc = col - 1024;
                float* op = nullptr;
                if (m >= MPR) op = out + O_KS + (size_t)(m - MPR) * 1024 + hc;
                else { const int t = m & (SEQ - 1), b = m >> 11; if (t >= SEQ - 512) op = out + O_KP + ((size_t)b * 512 + (t - (SEQ - 512))) * 1024 + hc; }
                if (op) { *(f32x4*)op = (f32x4){y[0], y[1], y[2], y[3]}; *(f32x4*)(op + 4) = (f32x4){y[4], y[5], y[6], y[7]}; }
            } else {
#pragma unroll
                for (int j = 0; j < 8; ++j) y[j] *= 0.125f;
            }
            u32x4 o; o.x = pk2(y[0], y[1]); o.y = pk2(y[2], y[3]); o.z = pk2(y[4], y[5]); o.w = pk2(y[6], y[7]);
            *(u32x4*)(QK + (size_t)m * 2048 + col) = o; }
    }
#if REPEAT_SUB == 3
    for (int rep3 = 0; rep3 < 2; ++rep3) {
#else
    {
#endif
    { bf16_t* KC = (bf16_t*)(ws + WS_KC); bf16_t* VTC = (bf16_t*)(ws + WS_VTC);
      for (int i = blk * 512 + tid; i < 8 * 512 * 1024 / 8; i += G * 512) { const f32x4 a0 = __builtin_nontemporal_load((const f32x4*)(p.in[I_CK] + (size_t)i * 8)), a1 = __builtin_nontemporal_load((const f32x4*)(p.in[I_CK] + (size_t)i * 8 + 4));
          u32x4 o; o.x = pk2(a0.x, a0.y); o.y = pk2(a0.z, a0.w); o.z = pk2(a1.x, a1.y); o.w = pk2(a1.z, a1.w); *(u32x4*)(KC + (size_t)i * 8) = o; }
      for (int task = gw; task < 8 * 16 * 8; task += NGW) { const int jb = task & 7, cb = (task >> 3) & 15, b = task >> 7; const int c = cb * 64 + lane;
          float v[64];
#pragma unroll
          for (int j = 0; j < 64; ++j) v[j] = __builtin_nontemporal_load(p.in[I_CV] + ((size_t)b * 512 + jb * 64 + j) * 1024 + c);
#pragma unroll
          for (int q = 0; q < 8; ++q) { u32x4 o; o.x = pk2(v[8 * q], v[8 * q + 1]); o.y = pk2(v[8 * q + 2], v[8 * q + 3]); o.z = pk2(v[8 * q + 4], v[8 * q + 5]); o.w = pk2(v[8 * q + 6], v[8 * q + 7]);
              *(u32x4*)(VTC + ((size_t)b * 1024 + c) * 512 + jb * 64 + 8 * q) = o; } }
    }
    { const size_t gt = (size_t)blk * 512 + tid, NT = (size_t)G * 512;
      for (size_t i = gt; i < (size_t)12 * DSH; i += NT) { const int r = (int)(i / DSH), c = (int)(i % DSH);
          if (r < 4) out[O_SHP + (size_t)r * DSH + c] = bf1(ZR[(size_t)(r * SEQ + SEQ - 1) * DSH + c]);
          else out[O_SHS + (size_t)(r - 4) * DSH + c] = bf1(ZR[(size_t)(MPR + (r - 4) * 16 + 15) * DSH + c]); }
    }
    const bf16_t* LT = (const bf16_t*)(ws + WS_LT);
    float* FW = (float*)(ws + WS_FW); bf16_t* FB = (bf16_t*)(ws + WS_FB); bf16_t* FV = (bf16_t*)(ws + WS_FV); bf16_t* GG = (bf16_t*)(ws + WS_GG); float* BON = (float*)(ws + WS_BONUS);
    const float* SSH = p.in[I_SS]; const float* MU = p.in[I_MU];
    LAS unsigned char* Ap = lds;
    LAS bf16_t* zt = (LAS bf16_t*)(lds + 16896 + wave * 13200);
    const int n0 = lane & 31, hf0 = lane >> 5;
    for (;;) {
        LAS int* tslot = (LAS int*)(lds + 130944);
        __syncthreads();
        if (tid == 0) *tslot = (int)atomicAdd((unsigned*)(ws + WS_CTR) + 64, 1u);
        __syncthreads();
        const int task = *tslot; if (task >= 520) break;
        const int m0 = (task >> 1) * 32; const bool samp = m0 >= MPR;
        int hf = hf0; asm volatile("" : "+v"(hf));
        __syncthreads();
        {
            const int tk = tid >> 4, cc = (tid & 15) * 16; const int m = m0 + tk;
            const int t = samp ? ((m - MPR) & 15) : (m & (SEQ - 1)); const int bs = samp ? ((m - MPR) >> 4) : 0; const int mp = t > 0 ? m - 1 : m;
            float z[16], zp[16];
            unpack8(*(const u32x4*)(ZR + (size_t)m * DSH + 3072 + cc), z); unpack8(*(const u32x4*)(ZR + (size_t)m * DSH + 3072 + cc + 8), z + 8);
            unpack8(*(const u32x4*)(ZR + (size_t)mp * DSH + 3072 + cc), zp); unpack8(*(const u32x4*)(ZR + (size_t)mp * DSH + 3072 + cc + 8), zp + 8);
            float o[16];
#pragma unroll
            for (int j4 = 0; j4 < 4; ++j4) { const f32x4 mu4 = *(const f32x4*)(MU + 3072 + cc + 4 * j4), st4 = *(const f32x4*)(SSH + (size_t)bs * DSH + 3072 + cc + 4 * j4);
#pragma unroll
                for (int e = 0; e < 4; ++e) { const int j = 4 * j4 + e; const float pv = t > 0 ? zp[j] : (samp ? st4[e] : 0.f); float v = z[j] + (pv - z[j]) * mu4[e];
                    if (cc < 64) v = 1.f - 2.f / (1.f + __expf(2.f * v)); else if (cc >= 128) v = sigmoidf_(v);
                    o[j] = v; } }
            u32x4 q0, q1; q0.x = pk2(o[0], o[1]); q0.y = pk2(o[2], o[3]); q0.z = pk2(o[4], o[5]); q0.w = pk2(o[6], o[7]); q1.x = pk2(o[8], o[9]); q1.y = pk2(o[10], o[11]); q1.z = pk2(o[12], o[13]); q1.w = pk2(o[14], o[15]);
            *(LAS u32x4*)(Ap + tk * 528 + cc * 2) = q0; *(LAS u32x4*)(Ap + tk * 528 + cc * 2 + 16) = q1;
        }
        __syncthreads();
        bf16x8 Bf[16];
#pragma unroll
        for (int s = 0; s < 16; ++s) Bf[s] = *(const LAS bf16x8*)(Ap + n0 * 528 + (16 * s + 8 * hf) * 2);
#pragma unroll 1
        for (int hh = (task & 1); hh <= (task & 1); ++hh) { const int h = wave * 2 + hh;
            int n = n0; asm volatile("" : "+v"(hf), "+v"(n));
            for (int q = lane; q < 33 * 24; q += 64) { const int row = q / 24, seg = q - row * 24, vec = seg >> 3, part = seg & 7; int mr = m0 - 1 + row; mr = mr < 0 ? 0 : mr;
                *(LAS u32x4*)(zt + row * 200 + vec * 64 + part * 8) = *(const u32x4*)(ZR + (size_t)mr * DSH + vec * 1024 + h * 64 + part * 8); }
#pragma unroll 1
            for (int b2 = 0; b2 < 2; ++b2) { f32x16 ag; for (int i = 0; i < 16; ++i) ag[i] = 0.f;
                const int c = h * 64 + b2 * 32 + n; const bf16_t* lt = LT + (size_t)c * 256 + 8 * hf;
#pragma unroll
                for (int s = 8; s < 16; ++s) ag = MFMA32(Bf[s], *(const bf16x8*)(lt + 16 * s), ag);
#pragma unroll
                for (int i = 0; i < 16; ++i) GG[(size_t)(m0 + crow(i, hf)) * 1024 + c] = (bf16_t)(pk2(ag[i], 0.f) & 0xffffu); }
#define ZS(vec, cl, i, muv, stv) ({ const int ti_ = crow(i, hf); const float z_ = bf1(zt[(ti_ + 1) * 200 + (vec) * 64 + (cl)]); float pv_ = bf1(zt[ti_ * 200 + (vec) * 64 + (cl)]); \
                if ((i) == 0 || (i) == 8) { const int m_ = m0 + ti_; const int t_ = samp ? ((m_ - MPR) & 15) : (m_ & (SEQ - 1)); if (t_ == 0) pv_ = samp ? (stv) : 0.f; } z_ + (pv_ - z_) * (muv); })
            float ssq[16];
#pragma unroll
            for (int i = 0; i < 16; ++i) ssq[i] = 0.f;
#pragma unroll
            for (int b2 = 0; b2 < 2; ++b2) { const int cl = b2 * 32 + n, c = h * 64 + cl; const float kkw = p.in[I_KK][c], muk = MU[1024 + c];
                const int bs0 = samp ? ((m0 - MPR) >> 4) : 0; const float st0 = SSH[(size_t)bs0 * DSH + 1024 + c], st1 = SSH[(size_t)(samp ? bs0 + 1 : 0) * DSH + 1024 + c];
#pragma unroll
                for (int i = 0; i < 16; ++i) { const float kv = ZS(1, cl, i, muk, (i == 0 ? st0 : st1)); const float q = kv * kkw; ssq[i] += q * q; } }
            float inv[16];
#pragma unroll
            for (int i = 0; i < 16; ++i) { float v = row16_sum(ssq[i]); v += __shfl_xor(v, 16); inv[i] = 1.f / fmaxf(sqrtf(v), 1e-12f); }
            float bon[16];
#pragma unroll
            for (int i = 0; i < 16; ++i) bon[i] = 0.f;
#pragma unroll 1
            for (int b2 = 0; b2 < 2; ++b2) { asm volatile("" : "+v"(hf), "+v"(n)); const int cl = b2 * 32 + n, c = h * 64 + cl;
                f32x16 aw, aa; for (int i = 0; i < 16; ++i) { aw[i] = 0.f; aa[i] = 0.f; }
                const bf16_t* lt = LT + (size_t)c * 256 + 8 * hf;
#pragma unroll
                for (int s = 0; s < 4; ++s) aw = MFMA32(Bf[s], *(const bf16x8*)(lt + 16 * s), aw);
#pragma unroll
                for (int s = 4; s < 8; ++s) aa = MFMA32(Bf[s], *(const bf16x8*)(lt + 16 * s), aa);
                const float w0 = p.in[I_W0][c], a0 = p.in[I_A0][c], kkw = p.in[I_KK][c], kaw = p.in[I_KA][c], rkw = p.in[I_RK][c], mur = MU[c], muk = MU[1024 + c], muv = MU[2048 + c];
                const int bs0 = samp ? ((m0 - MPR) >> 4) : 0, bs1 = samp ? bs0 + 1 : 0;
                const float sr0 = SSH[(size_t)bs0 * DSH + c], sr1 = SSH[(size_t)bs1 * DSH + c], sk0 = SSH[(size_t)bs0 * DSH + 1024 + c], sk1 = SSH[(size_t)bs1 * DSH + 1024 + c], sv0 = SSH[(size_t)bs0 * DSH + 2048 + c], sv1 = SSH[(size_t)bs1 * DSH + 2048 + c];
#pragma unroll
                for (int i = 0; i < 16; ++i) { const int m = m0 + crow(i, hf);
                    const float rz = ZS(0, cl, i, mur, (i == 0 ? sr0 : sr1)), kv = ZS(1, cl, i, muk, (i == 0 ? sk0 : sk1)), vz = ZS(2, cl, i, muv, (i == 0 ? sv0 : sv1));
                    const float wl = w0 + aw[i];
                    const float y = -wl; const float sp = fmaxf(y, 0.f) + __logf(1.f + __expf(-fabsf(y)));
                    const float dec = __expf(-__expf(-sp - 0.5f));
                    const float av = sigmoidf_(a0 + aa[i]);
                    const float kk = kv * kkw * inv[i], kp = kv * (1.f + (av - 1.f) * kaw), kka = kk * av;
                    bon[i] += rz * kp * rkw;
                    __builtin_nontemporal_store(dec, FW + ((size_t)m * 16 + h) * 64 + cl);
                    bf16_t* fb = FB + ((size_t)m * 16 + h) * 256 + cl;
                    __builtin_nontemporal_store((bf16_t)(pk2(rz, 0.f) & 0xffffu), fb); __builtin_nontemporal_store((bf16_t)(pk2(kp, 0.f) & 0xffffu), fb + 64);
                    __builtin_nontemporal_store((bf16_t)(pk2(kk, 0.f) & 0xffffu), fb + 128); __builtin_nontemporal_store((bf16_t)(pk2(kka, 0.f) & 0xffffu), fb + 192);
                    __builtin_nontemporal_store((bf16_t)(pk2(vz, 0.f) & 0xffffu), FV + (size_t)m * 1024 + c); __builtin_amdgcn_sched_barrier(0); }
            }
#undef ZS
#pragma unroll
            for (int i = 0; i < 16; ++i) { float v = row16_sum(bon[i]); v += __shfl_xor(v, 16); if (n == 0) BON[(size_t)(m0 + crow(i, hf)) * 16 + h] = v; }
        }
    }
    }
}

constexpr int SC_TC = 16, SC_NB = 4, SC_BUFB = SC_TC * 1280 + SC_TC * 64;
constexpr int L_FLAGS = SC_NB * SC_BUFB, L_TBL = L_FLAGS + 64, L_KV = L_TBL + 8 * 1040, KV_STRIDE = 144, KV_BYTES = 2 * 64 * KV_STRIDE;
DI void scan_run(const Params& p, LAS unsigned char* lds, const int wave, const int lane, const int blk, const int G) {
    unsigned char* ws = p.ws; float* out = p.out;
    const float* FW = (const float*)(ws + WS_FW); const bf16_t* FB = (const bf16_t*)(ws + WS_FB); const bf16_t* FV = (const bf16_t*)(ws + WS_FV); float* Y = (float*)(ws + WS_Y);
    LAS unsigned* ready = (LAS unsigned*)(lds + L_FLAGS); LAS unsigned* done = ready + SC_NB;
    unsigned gc = 0;
    for (int u = blk; u < 768; u += G) {
        int m0, T, h, rg; const float* S0; float* Sout;
        if (u < 256) { const int bh = u >> 2; rg = u & 3; h = bh & 15; m0 = (bh >> 4) * SEQ; T = SEQ; S0 = nullptr; Sout = out + O_SP + (size_t)bh * 4096; }
        else { const int su = u - 256, bh = su >> 2; rg = su & 3; h = bh & 15; m0 = MPR + (bh >> 4) * 16; T = 16; S0 = p.in[I_SR] + (size_t)bh * 4096; Sout = out + O_SS + (size_t)bh * 4096; }
        const int nch = T / SC_TC;
        if (wave >= 4) {
            const int lw = wave - 4; const int cstart = (int)((gc + (unsigned)lw) & 1u); const int nmine = (nch - cstart + 1) >> 1;
            f32x4 fw[3][4]; u32x4 fb[3][8]; u32x4 fv[3];
#define FEED_ISSUE(slot, jidx) do { const int _j = (jidx) < nmine ? (jidx) : nmine - 1; const int _mb = m0 + (cstart + 2 * _j) * SC_TC; \
                _Pragma("unroll") for (int i = 0; i < 4; ++i) { const int idx = i * 64 + lane, st = idx >> 4, q = idx & 15; fw[slot][i] = *(const f32x4*)(FW + ((size_t)(_mb + st) * 16 + h) * 64 + q * 4); } \
                _Pragma("unroll") for (int i = 0; i < 8; ++i) { const int idx = i * 64 + lane, st = idx >> 5, q = idx & 31; fb[slot][i] = *(const u32x4*)(FB + ((size_t)(_mb + st) * 16 + h) * 256 + q * 8); } \
                fv[slot] = *(const u32x4*)(FV + (size_t)(_mb + ((lane & 31) >> 1)) * 1024 + h * 64 + rg * 16 + (lane & 1) * 8); } while (0)
            if (nmine > 0) {
                FEED_ISSUE(0, 0); FEED_ISSUE(1, 1);
                for (int j0 = 0; j0 < nmine; j0 += 3) {
#pragma unroll
                    for (int jj = 0; jj < 3; ++jj) { const int j = j0 + jj;
                        if (j < nmine) {
                            FEED_ISSUE((jj + 2) % 3, j + 2);
                            const unsigned g = gc + (unsigned)(cstart + 2 * j); const int b = g & (SC_NB - 1);
                            if (g >= SC_NB) { const unsigned target = 4u * (g / SC_NB); while (__hip_atomic_load(done + b, __ATOMIC_RELAXED, __HIP_MEMORY_SCOPE_WORKGROUP) < target) __builtin_amdgcn_s_sleep(1); asm volatile("" ::: "memory"); }
                            LAS unsigned char* buf = lds + b * SC_BUFB;
#pragma unroll
                            for (int i = 0; i < 4; ++i) { const int idx = i * 64 + lane, st = idx >> 4, q = idx & 15; *(LAS f32x4*)(buf + st * 1280 + q * 16) = fw[jj][i]; }
#pragma unroll
                            for (int i = 0; i < 8; ++i) { const int idx = i * 64 + lane, st = idx >> 5, q = idx & 31; float f[8]; unpack8(fb[jj][i], f);
                                LAS float* d = (LAS float*)(buf + st * 1280 + 256 + q * 32); *(LAS f32x4*)d = (f32x4){f[0], f[1], f[2], f[3]}; *(LAS f32x4*)(d + 4) = (f32x4){f[4], f[5], f[6], f[7]}; }
                            if (lane < 32) { float f[8]; unpack8(fv[jj], f); LAS float* d = (LAS float*)(buf + SC_TC * 1280 + (lane >> 1) * 64 + (lane & 1) * 32);
                                *(LAS f32x4*)d = (f32x4){f[0], f[1], f[2], f[3]}; *(LAS f32x4*)(d + 4) = (f32x4){f[4], f[5], f[6], f[7]}; }
                            asm volatile("" ::: "memory");
                            if (lane == 0) __hip_atomic_store(ready + b, g + 1u, __ATOMIC_RELAXED, __HIP_MEMORY_SCOPE_WORKGROUP);
                            asm volatile("" ::: "memory");
                        }
                    }
                }
            }
#undef FEED_ISSUE
        } else {
            const int rl = wave * 4 + (lane >> 4), kq = lane & 15, row = rg * 16 + rl;
            f32x2 Sa = (f32x2){0.f, 0.f}, Sb = (f32x2){0.f, 0.f};
            if (S0) { const f32x4 s4 = *(const f32x4*)(S0 + row * 64 + kq * 4); Sa = (f32x2){s4.x, s4.y}; Sb = (f32x2){s4.z, s4.w}; }
            for (int c = 0; c < nch; ++c) { const unsigned g = gc + c; const int b = g & (SC_NB - 1);
                while (__hip_atomic_load(ready + b, __ATOMIC_RELAXED, __HIP_MEMORY_SCOPE_WORKGROUP) < g + 1u) __builtin_amdgcn_s_sleep(1);
                asm volatile("" ::: "memory");
                const LAS unsigned char* buf = lds + b * SC_BUFB;
                float ykeep = 0.f;
                f32x4 W_[3], R_[3], K_[3], KK_[3], KA_[3]; float V_[3];
#define SC_LOAD(slot, st) do { const LAS unsigned char* sb = buf + (st) * 1280 + kq * 16; W_[slot] = *(const LAS f32x4*)(sb); R_[slot] = *(const LAS f32x4*)(sb + 256); K_[slot] = *(const LAS f32x4*)(sb + 512); \
                    KK_[slot] = *(const LAS f32x4*)(sb + 768); KA_[slot] = *(const LAS f32x4*)(sb + 1024); V_[slot] = *(const LAS float*)(buf + SC_TC * 1280 + (st) * 64 + rl * 4); } while (0)
                SC_LOAD(0, 0); SC_LOAD(1, 1); SC_LOAD(2, 2);
#pragma unroll
                for (int st = 0; st < SC_TC; ++st) { const int sl = st % 3;
                    const f32x4 w4 = W_[sl], r4 = R_[sl], k4 = K_[sl], kk4 = KK_[sl], ka4 = KA_[sl]; const float vv = V_[sl];
                    f32x2 p2 = Sa * (f32x2){kk4.x, kk4.y}; p2 = Sb * (f32x2){kk4.z, kk4.w} + p2;
                    float pa = p2.x + p2.y; pa = row16_sum(pa);
                    const f32x2 Ta = Sa * (f32x2){w4.x, w4.y} + vv * (f32x2){k4.x, k4.y}, Tb = Sb * (f32x2){w4.z, w4.w} + vv * (f32x2){k4.z, k4.w};
                    Sa = Ta - pa * (f32x2){ka4.x, ka4.y}; Sb = Tb - pa * (f32x2){ka4.z, ka4.w};
                    f32x2 q2 = Sa * (f32x2){r4.x, r4.y}; q2 = Sb * (f32x2){r4.z, r4.w} + q2;
                    float qy = q2.x + q2.y; qy = row16_sum(qy);
                    ykeep = (kq == st) ? qy : ykeep;
                    if (st + 3 < SC_TC) SC_LOAD(sl, st + 3);
                }
#undef SC_LOAD
                asm volatile("" ::: "memory");
                if (lane == 0) __hip_atomic_fetch_add(done + b, 1u, __ATOMIC_RELAXED, __HIP_MEMORY_SCOPE_WORKGROUP);
                asm volatile("" ::: "memory");
                Y[(size_t)(m0 + c * SC_TC + kq) * 1024 + h * 64 + row] = ykeep;
            }
            *(f32x4*)(Sout + row * 64 + kq * 4) = (f32x4){Sa.x, Sa.y, Sb.x, Sb.y};
        }
        gc += nch;
    }
}

DI void attn_wave_task(const Params& p, LAS float* tbl, LAS unsigned char* kv, const int task, const int lane) {
    unsigned char* ws = p.ws;
    const bf16_t* QK = (const bf16_t*)(ws + WS_QK); const bf16_t* VT = (const bf16_t*)(ws + WS_VT); bf16_t* MIX = (bf16_t*)(ws + WS_MIXIN);
    const int c = 31 - (task >> 7), rem = task & 127, b = rem >> 5, h = (rem >> 1) & 15, half = rem & 1;
    for (int i = lane; i < 257; i += 64) tbl[i] = p.in[I_RB][h * 257 + i] * LOG2E;
    const int n = lane & 31, hf = lane >> 5;
    const int mq = b * SEQ + c * 64 + half * 32 + n;
    bf16x8 Qf[4];
#pragma unroll
    for (int s = 0; s < 4; ++s) Qf[s] = *(const bf16x8*)(QK + (size_t)mq * 2048 + h * 64 + 16 * s + 8 * hf);
    f32x16 O[2]; for (int i = 0; i < 16; ++i) { O[0][i] = 0.f; O[1][i] = 0.f; }
    float mrun = -1e30f, lrun = 0.f;
    const int kc0 = c - 8 < 0 ? 0 : c - 8;
    LAS unsigned char* kt = kv; LAS unsigned char* vt = kv + 64 * KV_STRIDE;
    const int srow = lane >> 3, spc = lane & 7;
    u32x4 kreg[8], vreg[8];
#define KV_FETCH(kcx) do { const bf16_t* kg = QK + (size_t)(b * SEQ + (kcx) * 64 + srow) * 2048 + 1024 + h * 64 + spc * 8; const bf16_t* vg = VT + (size_t)(h * 64 + srow) * MPAD + (size_t)b * SEQ + (kcx) * 64 + spc * 8; \
        _Pragma("unroll") for (int i = 0; i < 8; ++i) { kreg[i] = *(const u32x4*)(kg + (size_t)i * 8 * 2048); vreg[i] = *(const u32x4*)(vg + (size_t)i * 8 * MPAD); } } while (0)
#define KV_STORE() do { _Pragma("unroll") for (int i = 0; i < 8; ++i) { *(LAS u32x4*)(kt + (i * 8 + srow) * KV_STRIDE + spc * 16) = kreg[i]; *(LAS u32x4*)(vt + (i * 8 + srow) * KV_STRIDE + spc * 16) = vreg[i]; } } while (0)
    KV_FETCH(kc0);
    KV_STORE();
    for (int kc = kc0; kc <= c; ++kc) {
        { const int kn = kc < c ? kc + 1 : kc; KV_FETCH(kn); }
        f32x16 Sx[2];
#pragma unroll
        for (int kb = 0; kb < 2; ++kb) { for (int i = 0; i < 16; ++i) Sx[kb][i] = 0.f;
#pragma unroll
            for (int s = 0; s < 4; ++s) Sx[kb] = MFMA32(*(const LAS bf16x8*)(kt + (kb * 32 + n) * KV_STRIDE + 16 * hf + 32 * s), Qf[s], Sx[kb]); }
        const int dist0 = (c - kc) * 64 + half * 32 + n;
        float mx = -1e30f; float ebias = 0.f; const bool far = c - kc >= 3;
        if (far) { ebias = tbl[256];
#pragma unroll
            for (int kb = 0; kb < 2; ++kb)
#pragma unroll
                for (int i = 0; i < 16; ++i) mx = fmaxf(mx, Sx[kb][i]);
            mx = mx * LOG2E + ebias; }
        else {
#pragma unroll
            for (int kb = 0; kb < 2; ++kb)
#pragma unroll
                for (int i = 0; i < 16; ++i) { int rel = dist0 - kb * 32 - crow(i, hf); rel = rel < -128 ? -128 : (rel > 128 ? 128 : rel);
                    Sx[kb][i] = Sx[kb][i] * LOG2E + tbl[rel + 128]; mx = fmaxf(mx, Sx[kb][i]); } }
        mx = fmaxf(mx, __shfl_xor(mx, 32));
        const float mnew = fmaxf(mrun, mx); const float alpha = __builtin_amdgcn_exp2f(mrun - mnew); mrun = mnew;
        float ls = 0.f; const float esc = far ? LOG2E : 1.f, eoff = (far ? ebias : 0.f) - mnew;
#pragma unroll
        for (int kb = 0; kb < 2; ++kb)
#pragma unroll
            for (int i = 0; i < 16; ++i) { Sx[kb][i] = __builtin_amdgcn_exp2f(Sx[kb][i] * esc + eoff); ls += Sx[kb][i]; }
        lrun = lrun * alpha + ls;
#pragma unroll
        for (int i = 0; i < 16; ++i) { O[0][i] *= alpha; O[1][i] *= alpha; }
#pragma unroll
        for (int kb = 0; kb < 2; ++kb)
#pragma unroll
            for (int s2 = 0; s2 < 2; ++s2) {
                u32x4 pp; pp.x = pk2(Sx[kb][8 * s2], Sx[kb][8 * s2 + 1]); pp.y = pk2(Sx[kb][8 * s2 + 2], Sx[kb][8 * s2 + 3]); pp.z = pk2(Sx[kb][8 * s2 + 4], Sx[kb][8 * s2 + 5]); pp.w = pk2(Sx[kb][8 * s2 + 6], Sx[kb][8 * s2 + 7]);
                const bf16x8 Pf = __builtin_bit_cast(bf16x8, pp);
#pragma unroll
                for (int db = 0; db < 2; ++db) { const LAS unsigned char* vp = vt + (db * 32 + n) * KV_STRIDE + (kb * 32 + 16 * s2 + 4 * hf) * 2;
                    const s16x4 lo = *(const LAS s16x4*)vp, hi = *(const LAS s16x4*)(vp + 16);
                    const bf16x8 Vf = __builtin_shufflevector(lo, hi, 0, 1, 2, 3, 4, 5, 6, 7);
                    O[db] = MFMA32(Vf, Pf, O[db]); } }
        asm volatile("" ::: "memory");
        KV_STORE();
        asm volatile("" ::: "memory");
    }
#undef KV_FETCH
#undef KV_STORE
    const float l = lrun + __shfl_xor(lrun, 32); const float inv = 1.f / l;
#pragma unroll
    for (int db = 0; db < 2; ++db)
#pragma unroll
        for (int g4 = 0; g4 < 4; ++g4) { const int d0 = db * 32 + 8 * g4 + 4 * hf; u32x2 o; o.x = pk2(O[db][4 * g4] * inv, O[db][4 * g4 + 1] * inv); o.y = pk2(O[db][4 * g4 + 2] * inv, O[db][4 * g4 + 3] * inv);
            *(u32x2*)(MIX + (size_t)mq * 2048 + h * 64 + d0) = o; }
}

DI void attn_sample_wave(const Params& p, LAS float* tbl, const int bh, const int lane) {
    unsigned char* ws = p.ws;
    const bf16_t* QK = (const bf16_t*)(ws + WS_QK); const bf16_t* VT = (const bf16_t*)(ws + WS_VT); bf16_t* MIX = (bf16_t*)(ws + WS_MIXIN);
    const bf16_t* KC = (const bf16_t*)(ws + WS_KC); const bf16_t* VTC = (const bf16_t*)(ws + WS_VTC);
    const int b = bh >> 4, h = bh & 15;
    for (int i = lane; i < 257; i += 64) tbl[i] = p.in[I_RB][h * 257 + i] * LOG2E;
    const int n = lane & 31, hf = lane >> 5, qi = n & 15;
    const int mq = MPR + b * 16 + qi;
    bf16x8 Qf[4];
#pragma unroll
    for (int s = 0; s < 4; ++s) Qf[s] = *(const bf16x8*)(QK + (size_t)mq * 2048 + h * 64 + 16 * s + 8 * hf);
    f32x16 O[2]; for (int i = 0; i < 16; ++i) { O[0][i] = 0.f; O[1][i] = 0.f; }
    float mrun = -1e30f, lrun = 0.f;
#pragma unroll 1
    for (int kc = 0; kc < 9; ++kc) {
        f32x16 Sx[2];
#pragma unroll
        for (int kb = 0; kb < 2; ++kb) { for (int i = 0; i < 16; ++i) Sx[kb][i] = 0.f;
            const bf16_t* kp = kc < 8 ? KC + ((size_t)(b * 512 + kc * 64 + kb * 32 + n) * 1024 + h * 64 + 8 * hf) : QK + (size_t)(MPR + b * 16 + qi) * 2048 + 1024 + h * 64 + 8 * hf;
#pragma unroll
            for (int s = 0; s < 4; ++s) Sx[kb] = MFMA32(*(const bf16x8*)(kp + 16 * s), Qf[s], Sx[kb]); }
        s16x4 Vlo[2][2][2], Vhi[2][2][2];
#pragma unroll
        for (int kb = 0; kb < 2; ++kb)
#pragma unroll
            for (int s2 = 0; s2 < 2; ++s2)
#pragma unroll
                for (int db = 0; db < 2; ++db) { const bf16_t* vp = kc < 8 ? VTC + ((size_t)(b * 1024 + h * 64 + db * 32 + n) * 512 + kc * 64 + kb * 32 + 16 * s2 + 4 * hf)
                                                                       : VT + (size_t)(h * 64 + db * 32 + n) * MPAD + MPR + b * 16 + kb * 32 + 16 * s2 + 4 * hf;
                    Vlo[kb][s2][db] = *(const s16x4*)vp; Vhi[kb][s2][db] = *(const s16x4*)(vp + 8); }
        float mx = -1e30f;
#pragma unroll
        for (int kb = 0; kb < 2; ++kb)
#pragma unroll
            for (int i = 0; i < 16; ++i) { const int j = kc * 64 + kb * 32 + crow(i, hf); int rel = 512 + qi - j; rel = rel < -128 ? -128 : (rel > 128 ? 128 : rel);
                float sv = Sx[kb][i] * LOG2E + tbl[rel + 128]; sv = j < 528 ? sv : -1e30f; Sx[kb][i] = sv; mx = fmaxf(mx, sv); }
        mx = fmaxf(mx, __shfl_xor(mx, 32));
        const float mnew = fmaxf(mrun, mx); const float alpha = __builtin_amdgcn_exp2f(mrun - mnew); mrun = mnew;
        float ls = 0.f;
#pragma unroll
        for (int kb = 0; kb < 2; ++kb)
#pragma unroll
            for (int i = 0; i < 16; ++i) { Sx[kb][i] = __builtin_amdgcn_exp2f(Sx[kb][i] - mnew); ls += Sx[kb][i]; }
        lrun = lrun * alpha + ls;
#pragma unroll
        for (int i = 0; i < 16; ++i) { O[0][i] *= alpha; O[1][i] *= alpha; }
#pragma unroll
        for (int kb = 0; kb < 2; ++kb)
#pragma unroll
            for (int s2 = 0; s2 < 2; ++s2) {
                u32x4 pp; pp.x = pk2(Sx[kb][8 * s2], Sx[kb][8 * s2 + 1]); pp.y = pk2(Sx[kb][8 * s2 + 2], Sx[kb][8 * s2 + 3]); pp.z = pk2(Sx[kb][8 * s2 + 4], Sx[kb][8 * s2 + 5]); pp.w = pk2(Sx[kb][8 * s2 + 6], Sx[kb][8 * s2 + 7]);
                const bf16x8 Pf = __builtin_bit_cast(bf16x8, pp);
#pragma unroll
                for (int db = 0; db < 2; ++db) { const bf16x8 Vf = __builtin_shufflevector(Vlo[kb][s2][db], Vhi[kb][s2][db], 0, 1, 2, 3, 4, 5, 6, 7);
                    O[db] = MFMA32(Vf, Pf, O[db]); } }
    }
    const float l = lrun + __shfl_xor(lrun, 32); const float inv = 1.f / l;
    if (n < 16) {
#pragma unroll
        for (int db = 0; db < 2; ++db)
#pragma unroll
            for (int g4 = 0; g4 < 4; ++g4) { const int d0 = db * 32 + 8 * g4 + 4 * hf; u32x2 o; o.x = pk2(O[db][4 * g4] * inv, O[db][4 * g4 + 1] * inv); o.y = pk2(O[db][4 * g4 + 2] * inv, O[db][4 * g4 + 3] * inv);
                *(u32x2*)(MIX + (size_t)mq * 2048 + h * 64 + d0) = o; } }
}

DI void attn_sample_task(const Params& p, LAS unsigned char* lds, int bt, const int tid_o) {
    const int tid = tid_o, wave = tid >> 6, lane = tid & 63;
    unsigned char* ws = p.ws;
    const bf16_t* QK = (const bf16_t*)(ws + WS_QK); const bf16_t* VT = (const bf16_t*)(ws + WS_VT); bf16_t* MIX = (bf16_t*)(ws + WS_MIXIN);
    const int b = bt >> 4, h = bt & 15;
    LAS float* qs = (LAS float*)lds;
    LAS float* sc = qs + 1024;
    LAS float* tbl = sc + 16 * 528;
    LAS float* rinv = tbl + 260;
    __syncthreads();
    for (int i = tid; i < 1024; i += 512) qs[i] = bf1(QK[(size_t)(MPR + b * 16 + (i >> 6)) * 2048 + h * 64 + (i & 63)]);
    for (int i = tid; i < 257; i += 512) tbl[i] = p.in[I_RB][h * 257 + i];
    __syncthreads();
    for (int j = tid; j < 528; j += 512) {
        float kv[64];
        if (j < 512) { const float* kp = p.in[I_CK] + (((size_t)b * 512 + j) * 16 + h) * 64;
#pragma unroll
            for (int d = 0; d < 16; ++d) { const f32x4 v = *(const f32x4*)(kp + 4 * d); kv[4 * d] = v.x; kv[4 * d + 1] = v.y; kv[4 * d + 2] = v.z; kv[4 * d + 3] = v.w; } }
        else { const bf16_t* kp = QK + (size_t)(MPR + b * 16 + (j - 512)) * 2048 + 1024 + h * 64;
#pragma unroll
            for (int d = 0; d < 8; ++d) unpack8(*(const u32x4*)(kp + 8 * d), kv + 8 * d); }
        for (int i = 0; i < 16; ++i) { float s = 0.f;
#pragma unroll
            for (int d = 0; d < 64; ++d) s += qs[i * 64 + d] * kv[d];
            int rel = 512 + i - j; rel = rel < -128 ? -128 : (rel > 128 ? 128 : rel);
            sc[i * 528 + j] = s + tbl[rel + 128]; }
    }
    __syncthreads();
    for (int i = wave * 2; i < wave * 2 + 2; ++i) { float mx = -1e30f;
        for (int j = lane; j < 528; j += 64) mx = fmaxf(mx, sc[i * 528 + j]);
#pragma unroll
        for (int o = 1; o < 64; o <<= 1) mx = fmaxf(mx, __shfl_xor(mx, o));
        float sum = 0.f;
        for (int j = lane; j < 528; j += 64) { const float e = __expf(sc[i * 528 + j] - mx); sc[i * 528 + j] = e; sum += e; }
        sum = wave_sum(sum);
        if (lane == 0) rinv[i] = 1.f / sum; }
    __syncthreads();
    {
        LAS float* red = rinv + 16;
        const int d = tid & 63, kg = tid >> 6; float acc[16];
#pragma unroll
        for (int i = 0; i < 16; ++i) acc[i] = 0.f;
        const float* vp = p.in[I_CV] + ((size_t)b * 512 * 16 + h) * 64 + d;
        const bf16_t* vt = VT + (size_t)(h * 64 + d) * MPAD + MPR + b * 16;
#pragma unroll 1
        for (int j0 = kg * 66; j0 < kg * 66 + 66; j0 += 11) { float v[11];
#pragma unroll
            for (int u = 0; u < 11; ++u) { const int j = j0 + u; const int jc = j < 512 ? j : 511; const float vc = vp[(size_t)jc * 1024]; const float vn = bf1(vt[j < 512 ? 0 : j - 512]); v[u] = j < 512 ? vc : vn; }
#pragma unroll
            for (int u = 0; u < 11; ++u)
#pragma unroll
                for (int i = 0; i < 16; ++i) acc[i] += sc[i * 528 + j0 + u] * v[u]; }
#pragma unroll
        for (int i = 0; i < 16; ++i) red[(kg * 16 + i) * 64 + d] = acc[i];
        __syncthreads();
        for (int o = tid; o < 1024; o += 512) { const int i = o >> 6, dd = o & 63; float sum = 0.f;
#pragma unroll
            for (int g = 0; g < 8; ++g) sum += red[(g * 16 + i) * 64 + dd];
            MIX[(size_t)(MPR + b * 16 + i) * 2048 + h * 64 + dd] = (bf16_t)(pk2(sum * rinv[i], 0.f) & 0xffffu); }
    }
}

DI void phase_mix(const Params& p, LAS unsigned char* lds, const int tid_o) {
    const int blk = blockIdx.x, G = gridDim.x;
    const int wave = __builtin_amdgcn_readfirstlane(tid_o >> 6), lane = tid_o & 63;
    __syncthreads();
    if (tid_o < 2 * SC_NB + 4) ((LAS unsigned*)(lds + L_FLAGS))[tid_o] = 0u;
    __syncthreads();
    if (wave <= 3) __builtin_amdgcn_s_setprio(3);
    if (wave <= 5) { scan_run(p, lds, wave, lane, blk, G);
        LAS unsigned* sdone = (LAS unsigned*)(lds + L_FLAGS) + 8;
        asm volatile("" ::: "memory");
        if (lane == 0) __hip_atomic_fetch_add(sdone, 1u, __ATOMIC_RELAXED, __HIP_MEMORY_SCOPE_WORKGROUP);
        if (wave <= 3) { while (__hip_atomic_load(sdone, __ATOMIC_RELAXED, __HIP_MEMORY_SCOPE_WORKGROUP) < 6u) __builtin_amdgcn_s_sleep(1); asm volatile("" ::: "memory"); } }
#if REPEAT_SUB == 1
    __syncthreads();
    if (tid_o < 2 * SC_NB) ((LAS unsigned*)(lds + L_FLAGS))[tid_o] = 0u;
    __syncthreads();
    if (wave <= 5) scan_run(p, lds, wave, lane, blk, G);
#endif
    __builtin_amdgcn_s_setprio(0);
    if (wave <= 3 || wave >= 6) {
        LAS float* tbl = (LAS float*)(lds + L_TBL + wave * 1040);
        LAS unsigned char* kv = wave >= 6 ? lds + L_KV + (wave - 6) * KV_BYTES : lds + wave * KV_BYTES;
        const unsigned myq = (unsigned)__builtin_amdgcn_s_getreg((3 << 11) | 20) & 7u;
        for (unsigned qo = 0; qo < 8u; ++qo) { const unsigned q = (myq + qo) & 7u; unsigned* ctr = (unsigned*)(p.ws + WS_CTR) + 128 + 16 * q;
            for (;;) { unsigned t = 0; if (lane == 0) t = atomicAdd(ctr, 1u); t = __builtin_amdgcn_readfirstlane(t); if (t >= 528u) break;
                if (t < 16u) attn_sample_wave(p, tbl, (int)(q + 8u * t), lane);
                else { const unsigned tp = t - 16u, rem = tp & 15u, bhp = q + 8u * (rem >> 1); const int task = (int)((tp >> 4) * 128u + (bhp >> 4) * 32u + (bhp & 15u) * 2u + (rem & 1u));
                    attn_wave_task(p, tbl, kv, task, lane); } } }
    }
}

DI void phase_post(const Params& p, const int tid_o) {
    const int tid = tid_o, wave = tid >> 6, lane = tid & 63, blk = blockIdx.x, G = gridDim.x;
    unsigned char* ws = p.ws;
    const float* Y = (const float*)(ws + WS_Y); const bf16_t* FV = (const bf16_t*)(ws + WS_FV); const bf16_t* GG = (const bf16_t*)(ws + WS_GG); const float* BON = (const float*)(ws + WS_BONUS);
    bf16_t* MIX = (bf16_t*)(ws + WS_MIXIN);
    const int gw = blk * 8 + wave, NGW = G * 8;
    for (int i = blk * 512 + tid; i < MS * DM / 4; i += G * 512) *(f32x4*)(p.out + (size_t)MPR * DM + (size_t)i * 4) = *(const f32x4*)(p.in[I_XS] + (size_t)i * 4);
    { float* out = p.out; const bf16_t* VT = (const bf16_t*)(ws + WS_VT);
    for (int task = gw; task < 16 * 34; task += NGW) { const int cb = task & 15, mc = task >> 4; const int c = cb * 64 + lane;
        const int mbase = mc < 32 ? ((mc >> 3) * SEQ + (SEQ - 512) + (mc & 7) * 64) : MPR + (mc - 32) * 64;
        float* ob = mc < 32 ? out + O_VP + ((size_t)(mc >> 3) * 512 + (mc & 7) * 64) * 1024 + c : out + O_VS + (size_t)((mc - 32) * 64) * 1024 + c;
        u32x4 raw[8];
#pragma unroll
        for (int j = 0; j < 8; ++j) raw[j] = *(const u32x4*)(VT + (size_t)c * MPAD + mbase + 8 * j);
#pragma unroll
        for (int j = 0; j < 8; ++j) { float f[8]; unpack8(raw[j], f);
#pragma unroll
            for (int e = 0; e < 8; ++e) ob[(size_t)(8 * j + e) * 1024] = f[e]; __builtin_amdgcn_sched_barrier(0); } }
    }
    for (int m = gw; m < MT; m += NGW) {
#pragma unroll
        for (int it = 0; it < 2; ++it) { const int c = it * 512 + lane * 8, h = c >> 6;
            const f32x4 y0 = __builtin_nontemporal_load((const f32x4*)(Y + (size_t)m * 1024 + c)), y1 = __builtin_nontemporal_load((const f32x4*)(Y + (size_t)m * 1024 + c + 4));
            float y[8] = {y0.x, y0.y, y0.z, y0.w, y1.x, y1.y, y1.z, y1.w};
            float s = 0.f;
#pragma unroll
            for (int j = 0; j < 8; ++j) s += y[j];
            s += __shfl_xor(s, 1); s += __shfl_xor(s, 2); s += __shfl_xor(s, 4);
            const float mu = s * (1.f / 64.f); float v2 = 0.f;
#pragma unroll
            for (int j = 0; j < 8; ++j) { y[j] -= mu; v2 += y[j] * y[j]; }
            v2 += __shfl_xor(v2, 1); v2 += __shfl_xor(v2, 2); v2 += __shfl_xor(v2, 4);
            const float rstd = rsqrtf(v2 * (1.f / 64.f) + 64e-5f);
            float vv[8], gg[8]; unpack8(__builtin_nontemporal_load((const u32x4*)(FV + (size_t)m * 1024 + c)), vv); unpack8(__builtin_nontemporal_load((const u32x4*)(GG + (size_t)m * 1024 + c)), gg);
            const float bon = BON[(size_t)m * 16 + h];
            const float* lw = p.in[I_LW] + c; const float* lb = p.in[I_LB] + c;
            float o[8];
#pragma unroll
            for (int j = 0; j < 8; ++j) { const float yn = y[j] * rstd * lw[j] + lb[j]; o[j] = (yn + bon * vv[j]) * gg[j]; }
            u32x4 q; q.x = pk2(o[0], o[1]); q.y = pk2(o[2], o[3]); q.z = pk2(o[4], o[5]); q.w = pk2(o[6], o[7]);
            *(u32x4*)(MIX + (size_t)m * 2048 + 1024 + c) = q; }
    }
}

DI void phase_act(const Params& p, const int tid_o) {
    const int tid = tid_o, blk = blockIdx.x, G = gridDim.x;
    unsigned char* ws = p.ws; float* out = p.out;
    bf16_t* GV = (bf16_t*)(ws + WS_GV);
    const float* cst = p.in[I_SC];
    for (int it = blk * 512 + tid; it < 130 * 704; it += G * 512) {
        const int f = (it % 704) * 8, strip = it / 704, m0 = strip * 64;
        float w0[8], w1[8], w2[8], bb[8];
#pragma unroll
        for (int j = 0; j < 8; ++j) { w0[j] = p.in[I_DWC][f + j]; w1[j] = p.in[I_DWC][DFF + f + j]; w2[j] = p.in[I_DWC][2 * DFF + f + j]; bb[j] = p.in[I_DWB][f + j]; }
        float p1[8], p2[8];
        for (int r0 = 0; r0 < 64; r0 += 4) {
            u32x4 craw[4], vraw[4];
#pragma unroll
            for (int rr = 0; rr < 4; ++rr) { craw[rr] = __builtin_nontemporal_load((const u32x4*)(GV + (size_t)(m0 + r0 + rr) * (2 * DFF) + f)); vraw[rr] = __builtin_nontemporal_load((const u32x4*)(GV + (size_t)(m0 + r0 + rr) * (2 * DFF) + DFF + f)); }
#pragma unroll
            for (int rr = 0; rr < 4; ++rr) { const int r = r0 + rr, m = m0 + r;
                int t, b; const bool samp = m >= MPR; if (samp) { t = (m - MPR) & 15; b = (m - MPR) >> 4; } else { t = m & (SEQ - 1); b = m >> 11; }
                if (r == 0 || t == 0) {
#pragma unroll
                    for (int off = 1; off <= 2; ++off) { float* d = off == 1 ? p1 : p2;
                        if (t - off >= 0) unpack8(*(const u32x4*)(GV + (size_t)(m - off) * (2 * DFF) + f), d);
                        else if (samp) { const float* sp = cst + ((size_t)b * 2 + (2 + t - off)) * DFF + f;
#pragma unroll
                            for (int j = 0; j < 8; ++j) d[j] = sp[j]; }
                        else {
#pragma unroll
                            for (int j = 0; j < 8; ++j) d[j] = 0.f; } } }
                float cur[8], val[8]; unpack8(craw[rr], cur); unpack8(vraw[rr], val);
                float o[8];
#pragma unroll
                for (int j = 0; j < 8; ++j) { const float cv = bb[j] + w0[j] * p2[j] + w1[j] * p1[j] + w2[j] * cur[j]; o[j] = gelu_f(cv) * val[j]; }
                u32x4 q; q.x = pk2(o[0], o[1]); q.y = pk2(o[2], o[3]); q.z = pk2(o[4], o[5]); q.w = pk2(o[6], o[7]);
                *(u32x4*)(GV + (size_t)m * (2 * DFF) + DFF + f) = q;
                const int tl = samp ? 14 : SEQ - 2;
                if (t >= tl) { float* op = out + (samp ? O_CVS : O_CVP) + ((size_t)b * 2 + (t - tl)) * DFF + f;
                    *(f32x4*)op = (f32x4){cur[0], cur[1], cur[2], cur[3]}; *(f32x4*)(op + 4) = (f32x4){cur[4], cur[5], cur[6], cur[7]}; }
#pragma unroll
                for (int j = 0; j < 8; ++j) { p2[j] = p1[j]; p1[j] = cur[j]; }
            }
        }
    }
}

#define XB_TMO      128
#define XB_XCNT(j)  (256  + 64 * (j))
#define XB_XSUB(j)  (1280 + 64 * (j))
#define XB_XGEN(j)  (2304 + 64 * (j))
#define XB_TOP      3328
#define XB_TOPGEN   3392
#define XCD_BAR_WORDS 3456
#define XB_SPIN_CAP (1u << 20)
DI unsigned xb_ld(unsigned* p)              { return __hip_atomic_load(p, __ATOMIC_RELAXED, __HIP_MEMORY_SCOPE_AGENT); }
DI unsigned xb_add(unsigned* p, unsigned v) { return __hip_atomic_fetch_add(p, v, __ATOMIC_RELAXED, __HIP_MEMORY_SCOPE_AGENT); }
DI unsigned xb_xcc_id() { return (unsigned)__builtin_amdgcn_s_getreg((3 << 11) | 20) & 0xFu; }
#define XB_SPIN(cond, bar) do { unsigned _sp = 0; while (cond) { __builtin_amdgcn_s_sleep(1); \
    if ((++_sp & 255u) == 0u) { if (xb_ld(&(bar)[XB_TMO])) break; if (_sp > XB_SPIN_CAP) { atomicAdd(&(bar)[XB_TMO], 1u); break; } } } } while (0)
DI void xcd_barrier_complete(unsigned* bar, unsigned x, unsigned& nloc, unsigned& nx) {
    const unsigned G = gridDim.x;
    unsigned sum, cnt, mine, sp = 0u;
    for (;;) {
        sum = 0u; cnt = 0u; mine = 0u;
#pragma unroll
        for (unsigned j = 0; j < 16; ++j) { const unsigned c = xb_ld(&bar[XB_XCNT(j)]); sum += c; cnt += (c > 0u) ? 1u : 0u; mine = (j == x) ? c : mine; }
        if (sum == G) break;
        __builtin_amdgcn_s_sleep(1);
        if ((++sp & 255u) == 0u) { if (xb_ld(&bar[XB_TMO])) break; if (sp > XB_SPIN_CAP) { atomicAdd(&bar[XB_TMO], 1u); break; } }
    }
    nloc = mine > 0u ? mine : 1u; nx = cnt > 0u ? cnt : 1u;
}
DI void xcd_barrier(unsigned* bar, const unsigned x, volatile LAS unsigned* st, const int tid_o) {
    asm volatile("s_waitcnt vmcnt(0)" ::: "memory");
    __syncthreads();
    if (tid_o == 0) {
        __builtin_amdgcn_s_waitcnt(0);
        unsigned nloc = st[0], nx = st[1];
        if (nloc == 0u) { xcd_barrier_complete(bar, x, nloc, nx); st[0] = nloc; st[1] = nx; }
        const unsigned old = xb_add(&bar[XB_XSUB(x)], 1u);
        const unsigned gen = old / nloc;
        if (old + 1u == (gen + 1u) * nloc) {
            __builtin_amdgcn_fence(__ATOMIC_RELEASE, "agent");
            asm volatile("s_waitcnt vmcnt(0)" ::: "memory");
            const unsigned og = xb_add(&bar[XB_TOP], 1u);
            const unsigned tg = og / nx;
            if (og + 1u == (tg + 1u) * nx) xb_add(&bar[XB_TOPGEN], 1u);
            else XB_SPIN(xb_ld(&bar[XB_TOPGEN]) == tg, bar);
            __builtin_amdgcn_fence(__ATOMIC_ACQUIRE, "agent");
            xb_add(&bar[XB_XGEN(x)], 1u);
            asm volatile("s_waitcnt vmcnt(0)" ::: "memory");
        } else {
            XB_SPIN(xb_ld(&bar[XB_XGEN(x)]) == gen, bar);
            __builtin_amdgcn_fence(__ATOMIC_ACQUIRE, "agent");
            asm volatile("s_waitcnt vmcnt(0)" ::: "memory");
        }
    }
    __syncthreads();
}

constexpr int NPHASE = 10;
__global__ void __launch_bounds__(512, 2) mega(Params p) {
    extern __shared__ __attribute__((aligned(16))) unsigned char shm[];
    LAS unsigned char* lds = (LAS unsigned char*)shm;
    cg::grid_group grid = cg::this_grid();
    unsigned char* ws = p.ws;
    const int G = gridDim.x, c = blockIdx.x;
#if PROG == 1
    constexpr int PROGRAM[] = {0, 1, 2, 3, 2, 3, 4, 5, 6, 7, 8, 9, 10};
#elif PROG == 2
    constexpr int PROGRAM[] = {0, 1, 2, 3, 4, 5, 6, 7, 8, 9, 8, 9, 10};
#elif PROG == 3
    constexpr int PROGRAM[] = {0, 1, 2, 3, 4, 5, 6, 7, 8, 9, 10, 5, 6, 10};
#elif PROG == 4
    constexpr int PROGRAM[] = {0, 1, 2, 3, 4, 5, 6, 5, 6, 7, 8, 9, 10};
#elif PROG == 5
    constexpr int PROGRAM[] = {0, 1, 2, 3, 4, 2, 3, 4, 5, 6, 7, 8, 9, 10};
#elif PROG == 7
    constexpr int PROGRAM[] = {0, 1, 2, 3, 4, 5, 6, 7, 8, 9, 11, 10};
#elif PROG == 8
    constexpr int PROGRAM[] = {0, 12, 12, 12, 12, 12, 12, 12, 12, 12, 12, 1, 2, 3, 4, 5, 6, 7, 8, 9, 10};
#elif PROG == 6
    constexpr int PROGRAM[] = {0, 0, 1, 1, 2, 3, 4, 5, 6, 7, 7, 8, 9, 10};
#else
    constexpr int PROGRAM[] = {0, 1, 2, 3, 4, 5, 6, 7, 8, 9, 10, 13};
#endif
    constexpr int NPROG = sizeof(PROGRAM) / sizeof(int);
    unsigned* xbar = (unsigned*)(ws + WS_BAR); const unsigned xcc = xb_xcc_id(); volatile LAS unsigned* xst = (volatile LAS unsigned*)(lds + 132864);
    if (threadIdx.x < 4) xst[threadIdx.x] = 0u;
    if (threadIdx.x == 0) (void)xb_add(&xbar[XB_XCNT(xcc)], 1u);
    __syncthreads();
    for (int pi = p.ph_lo; pi < p.ph_hi; ++pi) {
        int ph = 0;
#pragma unroll
        for (int q = 0; q < NPROG; ++q) if (q == pi) ph = PROGRAM[q];
        int tid_o = threadIdx.x; asm volatile("" : "+v"(tid_o));
        switch (ph) {
#ifndef ONLY
#define ONLY -1
#endif
#define PHON(x) (ONLY < 0 || ONLY == (x))
        case 0: if (PHON(0)) phase0(p, lds, tid_o); break;
        case 1: if (PHON(1)) phase_norm<0>(p, lds, tid_o); break;
        case 2: if (PHON(2)) { SchedIn S; S.H = (const char*)(ws + WS_H); S.W = (const char*)(ws + WS_WT_IN); S.G = G; S.c = c; S.base = 0; S.limit = G == 256 ? 768 : 825;
                  EpiIn E; E.QK = (bf16_t*)(ws + WS_QK); E.VT = (bf16_t*)(ws + WS_VT); E.ZR = (bf16_t*)(ws + WS_ZR);
                  pg8::gemm_phase(lds, pg8::GemmK{DM, DM, DM}, S, E, tid_o);
                  } break;
        case 3: if (PHON(3)) phase_prep(p, lds, tid_o); break;
        case 4: if (PHON(4)) phase_mix(p, lds, tid_o);
#if REPEAT_SUB == 4
            grid.sync(); if (blockIdx.x == 0 && tid_o < 64) ((unsigned*)(ws + WS_CTR))[tid_o] = 0u; grid.sync(); phase_mix(p, lds, tid_o);
#endif
            break;
        case 5: if (PHON(5)) phase_post(p, tid_o); break;
        case 6: if (PHON(6)) { SchedPlain S; S.A = (const char*)(ws + WS_MIXIN); S.B = (const char*)(ws + WS_WT_OUT); S.G = G; S.c = c; S.nM = 32; S.nN = 8; S.nfull = 256; S.ntK = DM / 64; S.total = 256 + 8 * 8; S.astep = (size_t)256 * DM * 2; S.bstep = (size_t)256 * DM * 2;
                  EpiRes<false> E; E.out = p.out; E.xp = p.in[I_XP]; E.xs = p.in[I_XS]; E.MOD = (const float*)(ws + WS_MOD); E.goff = 2 * DM; E.slab = (float*)(ws + WS_FV);
                  pg8::gemm_phase(lds, pg8::GemmK{DM, DM, DM}, S, E, tid_o); } break;
        case 7: if (PHON(7)) phase_norm<1>(p, lds, tid_o); break;
        case 8: if (PHON(8)) { SchedPlain S; S.A = (const char*)(ws + WS_H); S.B = (const char*)(ws + WS_WT_UP); S.G = G; S.c = c; S.nM = 33; S.nN = 44; S.nfull = 33 * 44; S.ntK = DM / 64; S.total = 33 * 44; S.astep = (size_t)256 * DM * 2; S.bstep = (size_t)256 * DM * 2;
                  EpiUp E; E.GV = (bf16_t*)(ws + WS_GV);
                  pg8::gemm_phase(lds, pg8::GemmK{DM, DM, DM}, S, E, tid_o); } break;
        case 9: if (PHON(9)) phase_act(p, tid_o); break;
#if PROG == 7
        case 11: { SchedPlain S; S.A = (const char*)(ws + WS_GV) + (size_t)DFF * 2; S.B = (const char*)(ws + WS_WT_DOWN); S.G = G; S.c = c; S.nM = 32; S.nN = 8; S.nfull = 256; S.ntK = DFF / 64; S.total = 256 + 8 * 22; S.astep = (size_t)256 * (2 * DFF) * 2; S.bstep = (size_t)256 * DFF * 2;
                  EpiNull E; E.sink = (float*)(ws + WS_CTR + 1024);
                  pg8::gemm_phase(lds, pg8::GemmK{DFF, 2 * DFF, DFF}, S, E, tid_o); } break;
#endif
        case 13: {
            const float* slab = (const float*)(ws + WS_FV); const float* MOD = (const float*)(ws + WS_MOD);
            for (int i = blockIdx.x * 512 + tid_o; i < MS * DM / 4; i += G * 512) { const int r = i >> 9, c4 = (i & 511) * 4; f32x4 sum = (f32x4){0.f, 0.f, 0.f, 0.f};
#pragma unroll
                for (int ks = 0; ks < 22; ++ks) sum += *(const f32x4*)(slab + ((size_t)ks * MS + r) * DM + c4);
                const f32x4 g = *(const f32x4*)(MOD + (size_t)(4 + (r >> 4)) * NMOD + 5 * DM + c4); f32x4* op = (f32x4*)(p.out + (size_t)(MPR + r) * DM + c4); *op = *op + g * sum; }
            } break;
        case 10: if (PHON(10)) { SchedPlain S; S.A = (const char*)(ws + WS_GV) + (size_t)DFF * 2; S.B = (const char*)(ws + WS_WT_DOWN); S.G = G; S.c = c; S.nM = 32; S.nN = 8; S.nfull = 256; S.ntK = DFF / 64; S.total = 256 + 8 * 22; S.astep = (size_t)256 * (2 * DFF) * 2; S.bstep = (size_t)256 * DFF * 2;
                  EpiRes<true> E; E.out = p.out; E.xp = nullptr; E.xs = nullptr; E.MOD = (const float*)(ws + WS_MOD); E.goff = 5 * DM; E.slab = (float*)(ws + WS_FV);
                  pg8::gemm_phase(lds, pg8::GemmK{DFF, 2 * DFF, DFF}, S, E, tid_o); } break;
        }
        if (pi + 1 < p.ph_hi) { if (p.ph_hi < 0) grid.sync(); xcd_barrier(xbar, xcc, xst, tid_o); }
    }
}

extern "C" void kernel_launch(void* const* d_in, const int* in_sizes, int n_in, void* d_out, int out_size, void* d_ws, size_t ws_size, hipStream_t stream) {
    constexpr size_t kDynLds = 133120;
    static int grid_blocks = 0;
    if (!grid_blocks) {
        int dev = 0, cus = 0, per_cu = 0;
        hipGetDevice(&dev);
        hipDeviceGetAttribute(&cus, hipDeviceAttributeMultiprocessorCount, dev);
        hipFuncSetAttribute((const void*)mega, hipFuncAttributeMaxDynamicSharedMemorySize, (int)kDynLds);
        hipOccupancyMaxActiveBlocksPerMultiprocessor(&per_cu, (const void*)mega, 512, kDynLds);
        if (per_cu < 1) per_cu = 1;
        grid_blocks = cus * per_cu;
        if (grid_blocks > 256) grid_blocks = 256;
    }
    Params p{};
    for (int i = 0; i < 33; ++i) p.in[i] = (const float*)d_in[i];
    p.out = (float*)d_out; p.ws = (unsigned char*)d_ws;
#if N_LAUNCH_PER_PHASE
    for (int ph = 0; ph < 11; ++ph) { p.ph_lo = ph; p.ph_hi = ph + 1; hipLaunchKernelGGL(mega, dim3(grid_blocks), dim3(512), kDynLds, stream, p); }
#else
    hipMemsetAsync((unsigned char*)d_ws + WS_BAR, 0, 16384, stream);
    p.ph_lo = 0; p.ph_hi = (PROG == 0) ? 12 : (PROG == 8 ? 21 : PROG == 7 ? 12 : ((PROG == 3 || PROG == 5 || PROG == 6) ? 14 : 13));
    void* args[] = {&p};
    hipError_t e = hipLaunchCooperativeKernel((const void*)mega, dim3(grid_blocks), dim3(512), args, kDynLds, stream);
    if (e != hipSuccess) fprintf(stderr, "cooperative launch failed: %s (grid %d)\n", hipGetErrorString(e), grid_blocks);
#endif
}
```
